# Optimizing an MI355X kernel written in HIP

```python
import jax, jax.numpy as jnp
from jax import lax
import numpy as np

D_MODEL = 1024
BATCH = 4
SEQ = 8192
DEPTH = 4

N_META = 16
GRID_W = 64
N_MIXERS = 3
RMS_EPS = 1e-6
NA_HEADS = 16
NA_HEAD_DIM = D_MODEL // NA_HEADS
WIN_H = 8
WIN_W = 16
COL_QBLOCK = WIN_W
COL_KBLOCK = 2 * WIN_W
GQA_Q_HEADS = 16
GQA_KV_HEADS = 4
GQA_HEAD_DIM = D_MODEL // GQA_Q_HEADS
Q_BLOCK = 128
ROPE_THETA = 10000.0
ML_HEADS = 4
ML_QK_DIM = D_MODEL // (2 * ML_HEADS)
ML_V_DIM = D_MODEL // ML_HEADS
ML_CHUNK = 64
FFN_RAW = -(-8 * D_MODEL // 3)
FFN_HIDDEN = -(-FFN_RAW // 256) * 256

kernel_name = 'hybrid_natten_gqa_mlstm_encoder'


def rmsnorm(x, g):
    x32 = x.astype(jnp.float32)
    y = x32 * lax.rsqrt(jnp.mean(x32 * x32, axis=-1, keepdims=True) + RMS_EPS)
    return y.astype(x.dtype) * g


def swiglu(h, w1, w3, w2):
    return (jax.nn.silu(h @ w1) * (h @ w3)) @ w2


def neighbourhood_attention(h, w_qkv, rel_bias, meta_bias, w_o):
    b, l, d = h.shape
    t = l - N_META
    rows = t // GRID_W
    wh = min(WIN_H, rows)
    n_cb = GRID_W // COL_QBLOCK
    qkv = (h @ w_qkv).reshape(b, l, 3, NA_HEADS, NA_HEAD_DIM)
    q = qkv[:, :, 0] * (NA_HEAD_DIM ** -0.5)
    k = qkv[:, :, 1]
    v = qkv[:, :, 2]
    qm, km, vm = q[:, :N_META], k[:, :N_META], v[:, :N_META]
    qg = q[:, N_META:].reshape(b, rows, n_cb, COL_QBLOCK, NA_HEADS, NA_HEAD_DIM)
    kg = k[:, N_META:].reshape(b, rows, GRID_W, NA_HEADS, NA_HEAD_DIM)
    vg = v[:, N_META:].reshape(b, rows, GRID_W, NA_HEADS, NA_HEAD_DIM)
    q_cols = np.arange(GRID_W).reshape(n_cb, COL_QBLOCK)
    q_start = np.clip(q_cols - WIN_W // 2, 0, GRID_W - WIN_W)
    k_start = np.clip(np.arange(n_cb) * COL_QBLOCK - WIN_W // 2, 0, GRID_W - COL_KBLOCK)
    k_cols = k_start[:, None] + np.arange(COL_KBLOCK)
    kc = k_cols[:, None, :]
    col_ok = (kc >= q_start[..., None]) & (kc < q_start[..., None] + WIN_W)
    dc_idx = np.clip(kc - q_cols[..., None] + WIN_W - 1, 0, 2 * WIN_W - 2)
    bias_cols = rel_bias.astype(jnp.float32)[:, :, dc_idx]
    mb = meta_bias.astype(jnp.float32)

    def row_attend(args):
        r, q_row = args
        rs = jnp.clip(r - wh // 2, 0, rows - wh)
        k_rows = lax.dynamic_slice_in_dim(kg, rs, wh, axis=1)
        v_rows = lax.dynamic_slice_in_dim(vg, rs, wh, axis=1)
        k_blk = k_rows[:, :, k_cols]
        v_blk = v_rows[:, :, k_cols]
        s = jnp.einsum('bjqhd,bijkhd->bhjqik', q_row, k_blk).astype(jnp.float32)
        dr_idx = rs + jnp.arange(wh) - r + WIN_H - 1
        bias = jnp.transpose(bias_cols[:, dr_idx], (0, 2, 3, 1, 4))
        s = jnp.where(col_ok[:, :, None, :], s + bias[None], -jnp.inf)
        s = s.reshape(b, NA_HEADS, n_cb, COL_QBLOCK, wh * COL_KBLOCK)
        s_meta = jnp.einsum('bjqhd,bmhd->bhjqm', q_row, km).astype(jnp.float32) + mb[None, :, None, None, :]
        p = jax.nn.softmax(jnp.concatenate([s, s_meta], axis=-1), axis=-1).astype(h.dtype)
        p_win = p[..., :wh * COL_KBLOCK].reshape(b, NA_HEADS, n_cb, COL_QBLOCK, wh, COL_KBLOCK)
        p_meta = p[..., wh * COL_KBLOCK:]
        o = jnp.einsum('bhjqik,bijkhd->bjqhd', p_win, v_blk) + jnp.einsum('bhjqm,bmhd->bjqhd', p_meta, vm)
        return o.reshape(b, GRID_W, NA_HEADS * NA_HEAD_DIM)

    out_grid = lax.map(row_attend, (jnp.arange(rows), jnp.moveaxis(qg, 1, 0)))
    out_grid = jnp.moveaxis(out_grid, 0, 1).reshape(b, t, d)
    s_m = jnp.einsum('bqhd,bmhd->bhqm', qm, km).astype(jnp.float32) + mb[None, :, None, :]
    p_m = jax.nn.softmax(s_m, axis=-1).astype(h.dtype)
    out_meta = jnp.einsum('bhqm,bmhd->bqhd', p_m, vm).reshape(b, N_META, d)
    return jnp.concatenate([out_meta, out_grid], axis=1) @ w_o


def axial_rope_tables(l):
    t = l - N_META
    pos = jnp.arange(t, dtype=jnp.int32)
    zeros = jnp.zeros((N_META,), jnp.int32)
    row = jnp.concatenate([zeros, pos // GRID_W]).astype(jnp.float32)
    col = jnp.concatenate([zeros, pos % GRID_W]).astype(jnp.float32)
    sec = GQA_HEAD_DIM // 2
    freqs = 1.0 / (ROPE_THETA ** (jnp.arange(0, sec, 2, dtype=jnp.float32) / sec))
    ang_r = row[:, None] * freqs[None]
    ang_c = col[:, None] * freqs[None]
    return jnp.cos(ang_r), jnp.sin(ang_r), jnp.cos(ang_c), jnp.sin(ang_c)


def rotate_section(x, cos, sin):
    half = x.shape[-1] // 2
    x1, x2 = x[..., :half], x[..., half:]
    cos = cos[None, :, None, :].astype(x.dtype)
    sin = sin[None, :, None, :].astype(x.dtype)
    return jnp.concatenate([x1 * cos - x2 * sin, x2 * cos + x1 * sin], axis=-1)


def apply_axial_rope(x, tables):
    cos_r, sin_r, cos_c, sin_c = tables
    sec = x.shape[-1] // 2
    return jnp.concatenate([rotate_section(x[..., :sec], cos_r, sin_r),
                            rotate_section(x[..., sec:], cos_c, sin_c)], axis=-1)


def gqa_attention(h, w_qkv, q_norm, k_norm, w_o):
    b, l, d = h.shape
    t = l - N_META
    groups = GQA_Q_HEADS // GQA_KV_HEADS
    proj = h @ w_qkv
    nq = GQA_Q_HEADS * GQA_HEAD_DIM
    q = proj[..., :nq].reshape(b, l, GQA_Q_HEADS, GQA_HEAD_DIM)
    kv = proj[..., nq:].reshape(b, l, 2, GQA_KV_HEADS, GQA_HEAD_DIM)
    tables = axial_rope_tables(l)
    q = apply_axial_rope(rmsnorm(q, q_norm), tables) * (GQA_HEAD_DIM ** -0.5)
    k = apply_axial_rope(rmsnorm(kv[:, :, 0], k_norm), tables)
    v = kv[:, :, 1]

    def attend(qb):
        n = qb.shape[1]
        qb = qb.reshape(b, n, GQA_KV_HEADS, groups, GQA_HEAD_DIM)
        s = jnp.einsum('bqkgd,bskd->bkgqs', qb, k).astype(jnp.float32)
        p = jax.nn.softmax(s, axis=-1).astype(h.dtype)
        o = jnp.einsum('bkgqs,bskd->bqkgd', p, v)
        return o.reshape(b, n, GQA_Q_HEADS * GQA_HEAD_DIM)

    out_meta = attend(q[:, :N_META])
    qr = q[:, N_META:].reshape(b, t // Q_BLOCK, Q_BLOCK, GQA_Q_HEADS, GQA_HEAD_DIM)
    out_real = lax.map(attend, jnp.moveaxis(qr, 1, 0))
    out_real = jnp.moveaxis(out_real, 0, 1).reshape(b, t, d)
    return jnp.concatenate([out_meta, out_real], axis=1) @ w_o


def mlstm_scan(q, k, v, log_i, log_f):
    b, n, nh, dk = q.shape
    dv = v.shape[-1]
    nc = n // ML_CHUNK

    def chunk4(a):
        return a.reshape(b, nc, ML_CHUNK, nh, a.shape[-1]).transpose(1, 0, 3, 2, 4)

    def chunk3(a):
        return a.reshape(b, nc, ML_CHUNK, nh).transpose(1, 0, 3, 2)

    tril = jnp.tril(jnp.ones((ML_CHUNK, ML_CHUNK), dtype=bool))

    def step(carry, inp):
        c_mat, n_vec, m = carry
        qc, kc, vc, li, lf = inp
        bcum = jnp.cumsum(lf, axis=-1)
        dmat = jnp.where(tril, bcum[..., :, None] - bcum[..., None, :] + li[..., None, :], -jnp.inf)
        inter = bcum + m[..., None]
        m_t = jnp.maximum(inter, jnp.max(dmat, axis=-1))
        w_intra = jnp.exp(dmat - m_t[..., None])
        w_inter = jnp.exp(inter - m_t)
        s = jnp.einsum('bhtd,bhsd->bhts', qc, kc) * w_intra
        num = jnp.einsum('bhts,bhsv->bhtv', s, vc) + w_inter[..., None] * jnp.einsum('bhvd,bhtd->bhtv', c_mat, qc)
        den = jnp.sum(s, axis=-1) + w_inter * jnp.einsum('bhd,bhtd->bht', n_vec, qc)
        h_out = num / jnp.maximum(jnp.abs(den), jnp.exp(-m_t))[..., None]
        b_last = bcum[..., -1]
        g = b_last[..., None] - bcum + li
        m_new = jnp.maximum(b_last + m, jnp.max(g, axis=-1))
        decay = jnp.exp(b_last + m - m_new)
        wk = jnp.exp(g - m_new[..., None])
        c_new = decay[..., None, None] * c_mat + jnp.einsum('bhs,bhsv,bhsd->bhvd', wk, vc, kc)
        n_new = decay[..., None] * n_vec + jnp.einsum('bhs,bhsd->bhd', wk, kc)
        return (c_new, n_new, m_new), h_out

    init = (jnp.zeros((b, nh, dv, dk), jnp.float32), jnp.zeros((b, nh, dk), jnp.float32),
            jnp.zeros((b, nh), jnp.float32))
    _, hs = lax.scan(step, init, (chunk4(q), chunk4(k), chunk4(v), chunk3(log_i), chunk3(log_f)))
    return hs.transpose(1, 0, 3, 2, 4).reshape(b, n, nh, dv)


def mlstm_mixer(h, w_in, gate_bias, out_norm, w_o):
    b, l, d = h.shape
    f32 = jnp.float32
    nqk = ML_HEADS * ML_QK_DIM
    nv = ML_HEADS * ML_V_DIM
    proj = h @ w_in
    q = proj[..., :nqk].reshape(b, l, ML_HEADS, ML_QK_DIM).astype(f32)
    k = proj[..., nqk:2 * nqk].reshape(b, l, ML_HEADS, ML_QK_DIM).astype(f32) * (ML_QK_DIM ** -0.5)
    v = proj[..., 2 * nqk:2 * nqk + nv].reshape(b, l, ML_HEADS, ML_V_DIM).astype(f32)
    o_pre = proj[..., 2 * nqk + nv:2 * nqk + 2 * nv].astype(f32)
    gates = proj[..., 2 * nqk + 2 * nv:].reshape(b, l, 4, ML_HEADS).astype(f32) + gate_bias.astype(f32)
    log_i_f, log_f_f = gates[:, :, 0], jax.nn.log_sigmoid(gates[:, :, 1])
    log_i_b, log_f_b = gates[:, :, 2], jax.nn.log_sigmoid(gates[:, :, 3])
    pad = ML_CHUNK - N_META

    def pad4(a):
        return jnp.pad(a, ((0, 0), (pad, 0), (0, 0), (0, 0)))

    def pad3(a, val):
        return jnp.pad(a, ((0, 0), (pad, 0), (0, 0)), constant_values=val)

    def flip(a):
        return jnp.flip(a, axis=1)

    qp, kp, vp = pad4(q), pad4(k), pad4(v)
    h_fwd = mlstm_scan(qp, kp, vp, pad3(log_i_f, -jnp.inf), pad3(log_f_f, 0.0))
    h_bwd = flip(mlstm_scan(flip(qp), flip(kp), flip(vp), flip(pad3(log_i_b, -jnp.inf)), flip(pad3(log_f_b, 0.0))))
    h_sum = (h_fwd + h_bwd)[:, pad:]
    h_n = rmsnorm(h_sum, out_norm.reshape(ML_HEADS, ML_V_DIM)).reshape(b, l, nv)
    out = (jax.nn.sigmoid(o_pre) * h_n).astype(h.dtype)
    return out @ w_o


def setup_inputs(seed: int = 0) -> dict:
    key = jax.random.key(seed)
    ks = jax.random.split(key, 24)
    f32 = jnp.float32
    n_a = len(range(0, DEPTH, N_MIXERS))
    n_b = len(range(1, DEPTH, N_MIXERS))
    n_c = len(range(2, DEPTH, N_MIXERS))

    def w(k, shape, fan_in):
        return jax.random.normal(k, shape, f32) * (fan_in ** -0.5)

    def gain(k, shape):
        return 1.0 + 0.05 * jax.random.normal(k, shape, f32)

    gqa_cols = (GQA_Q_HEADS + 2 * GQA_KV_HEADS) * GQA_HEAD_DIM
    ml_cols = 2 * ML_HEADS * ML_QK_DIM + 2 * ML_HEADS * ML_V_DIM + 4 * ML_HEADS
    ib = 0.1 * jax.random.normal(ks[15], (n_c, 2, ML_HEADS), f32)
    fb = jnp.linspace(3.0, 6.0, ML_HEADS, dtype=f32) + 0.1 * jax.random.normal(ks[16], (n_c, 2, ML_HEADS), f32)
    c_gate_bias = jnp.stack([ib[:, 0], fb[:, 0], ib[:, 1], fb[:, 1]], axis=1)
    return {
        'x': jax.random.normal(ks[0], (BATCH, SEQ, D_MODEL), f32),
        'meta_tokens': jax.random.normal(ks[1], (N_META, D_MODEL), f32),
        'norm_mix': gain(ks[2], (DEPTH, D_MODEL)),
        'norm_ffn': gain(ks[3], (DEPTH, D_MODEL)),
        'norm_final': gain(ks[4], (D_MODEL,)),
        'a_w_qkv': w(ks[5], (n_a, D_MODEL, 3 * D_MODEL), D_MODEL),
        'a_rel_bias': 0.5 * jax.random.normal(ks[6], (n_a, NA_HEADS, 2 * WIN_H - 1, 2 * WIN_W - 1), f32),
        'a_meta_bias': 0.1 * jax.random.normal(ks[7], (n_a, NA_HEADS, N_META), f32),
        'a_w_o': w(ks[8], (n_a, D_MODEL, D_MODEL), D_MODEL),
        'b_w_qkv': w(ks[9], (n_b, D_MODEL, gqa_cols), D_MODEL),
        'b_q_norm': gain(ks[10], (n_b, GQA_HEAD_DIM)),
        'b_k_norm': gain(ks[11], (n_b, GQA_HEAD_DIM)),
        'b_w_o': w(ks[12], (n_b, D_MODEL, D_MODEL), D_MODEL),
        'c_w_in': w(ks[13], (n_c, D_MODEL, ml_cols), D_MODEL),
        'c_gate_bias': c_gate_bias,
        'c_out_norm': gain(ks[14], (n_c, ML_HEADS * ML_V_DIM)),
        'c_w_o': w(ks[17], (n_c, ML_HEADS * ML_V_DIM, D_MODEL), ML_HEADS * ML_V_DIM),
        'ffn_w1': w(ks[18], (DEPTH, D_MODEL, FFN_HIDDEN), D_MODEL),
        'ffn_w3': w(ks[19], (DEPTH, D_MODEL, FFN_HIDDEN), D_MODEL),
        'ffn_w2': w(ks[20], (DEPTH, FFN_HIDDEN, D_MODEL), FFN_HIDDEN),
    }


def reference(x, meta_tokens, norm_mix, norm_ffn, norm_final, a_w_qkv, a_rel_bias, a_meta_bias, a_w_o,
              b_w_qkv, b_q_norm, b_k_norm, b_w_o, c_w_in, c_gate_bias, c_out_norm, c_w_o,
              ffn_w1, ffn_w3, ffn_w2):
    b = x.shape[0]
    meta = jnp.broadcast_to(meta_tokens[None].astype(x.dtype), (b, N_META, x.shape[-1]))
    h = jnp.concatenate([meta, x], axis=1)
    for i in range(DEPTH):
        kind, j = i % N_MIXERS, i // N_MIXERS
        u = rmsnorm(h, norm_mix[i])
        if kind == 0:
            mix = neighbourhood_attention(u, a_w_qkv[j], a_rel_bias[j], a_meta_bias[j], a_w_o[j])
        elif kind == 1:
            mix = gqa_attention(u, b_w_qkv[j], b_q_norm[j], b_k_norm[j], b_w_o[j])
        else:
            mix = mlstm_mixer(u, c_w_in[j], c_gate_bias[j], c_out_norm[j], c_w_o[j])
        h = h + mix
        h = h + swiglu(rmsnorm(h, norm_ffn[i]), ffn_w1[i], ffn_w3[i], ffn_w2[i])
    return rmsnorm(h, norm_final)[:, N_META:]
```

```cpp
#include <hip/hip_runtime.h>
#include <hip/hip_cooperative_groups.h>
#include <hip/hip_bf16.h>
#include <cstdio>
#include <cstdint>
#include <cmath>
namespace cg = cooperative_groups;
namespace pg8 {
#define PG8_LAS __attribute__((address_space(3)))
typedef unsigned short bf16_t;
typedef short bf16x8 __attribute__((ext_vector_type(8)));
typedef float f32x4 __attribute__((ext_vector_type(4)));
typedef unsigned u32x4 __attribute__((ext_vector_type(4)));
constexpr int BM = 256, BK = 64, HALF = 128, HTB = HALF * BK * 2  , STAGE_BYTES = 8 * HTB, NXCD = 8, WGM = 8;

__host__ __device__ __forceinline__ int lds_byte(int r, int c) { const int st = (r >> 4) * 2 + (c >> 5), rr = r & 15, cc = c & 31, ob = rr * 64 + cc * 2; return st * 1024 + (ob ^ (((ob >> 9) & 1) << 5)); }
__host__ __device__ __forceinline__ void stage_rc(int b, int& R, int& C) { const int st = b / 1024, sb = b % 1024, swz = sb ^ (((sb >> 9) & 1) << 5); R = (st >> 1) * 16 + swz / 64; C = (st & 1) * 32 + (swz % 64) / 2; }
__host__ __device__ __forceinline__ int perm32(int rho) { const int n = rho >> 4, i = rho & 15; return 8 * (i >> 2) + 4 * n + (i & 3); }

struct Unit { int pm, pn; };
struct Gemm { const bf16_t* A; const bf16_t* Bt; int M, N, K; };

struct StaticOrder {
    int nM, nN, nwg, G, c;
    __host__ __device__ void init(int M, int N, int G_, int c_) { nM = M / BM; nN = N / BM; nwg = nM * nN; G = G_; c = c_; }
    __host__ __device__ bool next(int i, Unit& u) const {
        const long L = (long)i * G + c; if (L >= nwg) return false;
        int wgid = (int)L; { const int q = nwg / NXCD, r = nwg % NXCD, xcd = wgid % NXCD, off = wgid / NXCD; wgid = (xcd < r ? xcd * (q + 1) : r * (q + 1) + (xcd - r) * q) + off; }
        const int nig = WGM * nN, gid = wgid / nig, fm = gid * WGM, gsz = (nM - fm) < WGM ? (nM - fm) : WGM;
        u.pm = fm + ((wgid % nig) % gsz); u.pn = (wgid % nig) / gsz; return true;
    }
    __device__ __forceinline__ void a_ready(const Unit&) const {}
    __device__ __forceinline__ void done(const Unit&) const {}
};

__device__ __forceinline__ unsigned cvt_pk_bf16(float lo, float hi) { unsigned r; asm volatile("v_cvt_pk_bf16_f32 %0, %1, %2" : "=v"(r) : "v"(lo), "v"(hi)); return r; }
template <class Epi, class Sched, bool ALIGN_EPI = false, bool SP2 = false>
__device__ __forceinline__ void gemm_phase(PG8_LAS unsigned char* lds, const Gemm g, const Sched& S, const Epi& E) {
    int tid_ = threadIdx.x; asm volatile("" : "+v"(tid_));
    const int tid = tid_, wid = __builtin_amdgcn_readfirstlane(tid >> 6), lane = tid & 63, wr = wid >> 2, wc = wid & 3, fr = lane & 15, fq = lane >> 4;
    const int K = g.K, nt = K / BK;
    unsigned voffA[2], voffB[2];
#pragma unroll
    for (int i = 0; i < 2; ++i) { int R, C; stage_rc(tid * 16 + i * 8192, R, C); const int Rb = Epi::PERM ? ((R & ~31) + perm32(R & 31)) : R;
        voffA[i] = (unsigned)(R * K + C) * 2u; voffB[i] = (unsigned)(Rb * K + C) * 2u; }
    const size_t kstep = (size_t)(BK * 2);
    const size_t hstep = (size_t)HALF * K * 2;
    const size_t tstep = 2 * hstep;
    const unsigned ldsw = (unsigned)wid * 1024u;
    const int aoff = lds_byte(wr * 64 + fr, fq * 8), boff = lds_byte(wc * 32 + fr, fq * 8);
#define PG8_SA(b, h) (((b) * 2 + (h)) * HTB)
#define PG8_SB(b, h) ((4 + (b) * 2 + (h)) * HTB)
#define PG8_STAGE(bufoff, gbase, voff) do { _Pragma("unroll") for (int _i = 0; _i < 2; ++_i) \
        __builtin_amdgcn_global_load_lds((const unsigned*)((const char*)(gbase) + (voff)[_i]), (PG8_LAS unsigned*)(lds + (bufoff) + ldsw + _i * 8192), 16, 0, 0); } while (0)
#define PG8_LDA(dst, b, h) do { _Pragma("unroll") for (int m = 0; m < 4; ++m) _Pragma("unroll") for (int k = 0; k < 2; ++k) dst[m][k] = *(const PG8_LAS bf16x8*)(lds + PG8_SA(b, h) + aoff + m * 2048 + k * 1024); } while (0)
#define PG8_LDB(dst, b, h) do { _Pragma("unroll") for (int n = 0; n < 2; ++n) _Pragma("unroll") for (int k = 0; k < 2; ++k) dst[n][k] = *(const PG8_LAS bf16x8*)(lds + PG8_SB(b, h) + boff + n * 2048 + k * 1024); } while (0)
#define PG8_MMA(ai, bj, At, Bt) do { __builtin_amdgcn_s_setprio(1); _Pragma("unroll") for (int m = 0; m < 4; ++m) _Pragma("unroll") for (int n = 0; n < 2; ++n) _Pragma("unroll") for (int k = 0; k < 2; ++k) \
        acc[ai][bj][m][n] = __builtin_amdgcn_mfma_f32_16x16x32_bf16(Bt[n][k], At[m][k], acc[ai][bj][m][n], 0, 0, 0); __builtin_amdgcn_s_setprio(0); } while (0)
#define PG8_WAIT_V(n) asm volatile("s_waitcnt vmcnt(" #n ")" ::: "memory")
#define PG8_WAIT_L(n) asm volatile("s_waitcnt lgkmcnt(" #n ")" ::: "memory")
#define PG8_BAR __builtin_amdgcn_s_barrier()
#define PG8_SCHED __builtin_amdgcn_sched_barrier(0)
    Unit cur, nxt; int ui = 0;
    if (!S.next(0, cur)) return;
    f32x4 acc[2][2][4][2];
#pragma unroll
    for (int a = 0; a < 2; ++a)
#pragma unroll
        for (int b = 0; b < 2; ++b)
#pragma unroll
            for (int m = 0; m < 4; ++m)
#pragma unroll
                for (int n = 0; n < 2; ++n) acc[a][b][m][n] = (f32x4){0.f, 0.f, 0.f, 0.f};
    bf16x8 At[4][2], B0[2][2], B1[2][2];
    const char* cA = (const char*)g.A + (size_t)cur.pm * tstep; const char* cB = (const char*)g.Bt + (size_t)cur.pn * tstep;
    S.a_ready(cur);
    if constexpr (SP2) {
        PG8_STAGE(PG8_SB(0, 0), cB, voffB); PG8_STAGE(PG8_SB(0, 1), cB + hstep, voffB); PG8_STAGE(PG8_SA(0, 0), cA, voffA); PG8_STAGE(PG8_SA(0, 1), cA + hstep, voffA);
        if (wr == 1) PG8_BAR;
        PG8_WAIT_V(2); PG8_BAR;
        PG8_STAGE(PG8_SB(1, 0), cB + kstep, voffB); PG8_STAGE(PG8_SA(1, 0), cA + kstep, voffA); PG8_STAGE(PG8_SB(1, 1), cB + hstep + kstep, voffB);
        PG8_WAIT_V(6); PG8_BAR;
    } else {
        PG8_STAGE(PG8_SB(0, 0), cB, voffB); PG8_STAGE(PG8_SA(0, 0), cA, voffA); PG8_STAGE(PG8_SB(0, 1), cB + hstep, voffB); PG8_STAGE(PG8_SA(0, 1), cA + hstep, voffA);
        if (wr == 1) PG8_BAR;
        PG8_WAIT_V(4); PG8_BAR;
        PG8_STAGE(PG8_SB(1, 0), cB + kstep, voffB); PG8_STAGE(PG8_SA(1, 0), cA + kstep, voffA); PG8_STAGE(PG8_SB(1, 1), cB + hstep + kstep, voffB);
        PG8_WAIT_V(6); PG8_BAR;
    }
    for (;;) {
        const bool has_next = S.next(ui + 1, nxt);
        const char* nA = has_next ? (const char*)g.A + (size_t)nxt.pm * tstep : cA; const char* nB = has_next ? (const char*)g.Bt + (size_t)nxt.pn * tstep : cB;
        for (int t = 0; t < nt; t += 2) {
            const bool last = (t == nt - 2);
            const char* a1 = cA + (size_t)(t + 1) * kstep;
            const char* a2 = last ? nA : cA + (size_t)(t + 2) * kstep; const char* b2 = last ? nB : cB + (size_t)(t + 2) * kstep;
            const char* a3 = a2 + kstep; const char* b3 = b2 + kstep;
            if (last && has_next) S.a_ready(nxt);
            if constexpr (SP2) {
            PG8_LDB(B0, 0, 0); PG8_LDB(B1, 0, 1); PG8_SCHED; PG8_LDA(At, 0, 0); PG8_STAGE(PG8_SA(1, 1), a1 + hstep, voffA);
            PG8_WAIT_V(8); PG8_WAIT_L(0); PG8_BAR; PG8_MMA(0, 0, At, B0); PG8_MMA(0, 1, At, B1); PG8_BAR; PG8_SCHED;
            PG8_LDA(At, 0, 1); PG8_STAGE(PG8_SB(0, 0), b2, voffB); PG8_STAGE(PG8_SB(0, 1), b2 + hstep, voffB); PG8_STAGE(PG8_SA(0, 0), a2, voffA);
            PG8_WAIT_V(8); PG8_WAIT_L(0); PG8_BAR; PG8_MMA(1, 0, At, B0); PG8_MMA(1, 1, At, B1); PG8_BAR; PG8_SCHED;
            PG8_LDB(B0, 1, 0); PG8_LDB(B1, 1, 1); PG8_SCHED; PG8_LDA(At, 1, 0); PG8_STAGE(PG8_SA(0, 1), a2 + hstep, voffA);
            PG8_WAIT_V(8); PG8_WAIT_L(0); PG8_BAR; PG8_MMA(0, 0, At, B0); PG8_MMA(0, 1, At, B1); PG8_BAR; PG8_SCHED;
            PG8_LDA(At, 1, 1); PG8_STAGE(PG8_SB(1, 0), b3, voffB); PG8_STAGE(PG8_SB(1, 1), b3 + hstep, voffB); PG8_STAGE(PG8_SA(1, 0), a3, voffA);
            PG8_WAIT_V(8); PG8_WAIT_L(0); PG8_BAR; PG8_MMA(1, 0, At, B0); PG8_MMA(1, 1, At, B1); PG8_BAR; PG8_SCHED;
            } else {
            PG8_LDB(B0, 0, 0); PG8_SCHED; PG8_LDA(At, 0, 0); PG8_STAGE(PG8_SA(1, 1), a1 + hstep, voffA);
            PG8_WAIT_L(8); PG8_BAR; PG8_WAIT_L(0); PG8_MMA(0, 0, At, B0); PG8_BAR; PG8_SCHED;
            PG8_LDB(B1, 0, 1); PG8_STAGE(PG8_SB(0, 0), b2, voffB);
            PG8_BAR; PG8_WAIT_L(0); PG8_MMA(0, 1, At, B1); PG8_BAR;
            PG8_LDA(At, 0, 1); PG8_STAGE(PG8_SA(0, 0), a2, voffA);
            PG8_BAR; PG8_WAIT_L(0); PG8_MMA(1, 0, At, B0); PG8_BAR; PG8_SCHED;
            PG8_STAGE(PG8_SB(0, 1), b2 + hstep, voffB);
            PG8_WAIT_V(6); PG8_BAR; PG8_MMA(1, 1, At, B1); PG8_BAR;
            PG8_LDB(B0, 1, 0); PG8_SCHED; PG8_LDA(At, 1, 0); PG8_STAGE(PG8_SA(0, 1), a2 + hstep, voffA);
            PG8_WAIT_L(8); PG8_BAR; PG8_WAIT_L(0); PG8_MMA(0, 0, At, B0); PG8_BAR; PG8_SCHED;
            PG8_LDB(B1, 1, 1); PG8_STAGE(PG8_SB(1, 0), b3, voffB);
            PG8_BAR; PG8_WAIT_L(0); PG8_MMA(0, 1, At, B1); PG8_BAR;
            PG8_LDA(At, 1, 1); PG8_STAGE(PG8_SA(1, 0), a3, voffA);
            PG8_BAR; PG8_WAIT_L(0); PG8_MMA(1, 0, At, B0); PG8_BAR; PG8_SCHED;
            PG8_STAGE(PG8_SB(1, 1), b3 + hstep, voffB);
            PG8_WAIT_V(6); PG8_BAR; PG8_MMA(1, 1, At, B1); PG8_BAR;
            }
        }
        if constexpr (ALIGN_EPI) { if (wr == 0) PG8_BAR; }
        if constexpr (!Epi::AFTER_DRAIN) { E(acc, cur, wr, wc, fr, fq); S.done(cur); }
        if (!has_next) break;
#pragma unroll
        for (int a = 0; a < 2; ++a)
#pragma unroll
            for (int b = 0; b < 2; ++b)
#pragma unroll
                for (int m = 0; m < 4; ++m)
#pragma unroll
                    for (int n = 0; n < 2; ++n) acc[a][b][m][n] = (f32x4){0.f, 0.f, 0.f, 0.f};
        cur = nxt; cA = nA; cB = nB; ++ui;
        if constexpr (ALIGN_EPI) { if (wr == 1) PG8_BAR; }
    }
    PG8_WAIT_V(0);
    if constexpr (!ALIGN_EPI) { if (wr == 0) PG8_BAR; }
    PG8_BAR;
    if constexpr (Epi::AFTER_DRAIN) { E.fused(acc, cur, wr, wc, fr, fq, lds, wid, lane); S.done(cur); }
#undef PG8_SA
#undef PG8_SB
#undef PG8_STAGE
#undef PG8_LDA
#undef PG8_LDB
#undef PG8_MMA
#undef PG8_WAIT_V
#undef PG8_WAIT_L
#undef PG8_BAR
#undef PG8_SCHED
}
}
namespace attn_body {
using bf16=__hip_bfloat16;
using bf16x8=__attribute__((ext_vector_type(8)))short;
using s16x4=__attribute__((ext_vector_type(4)))short;
using f32x16=__attribute__((ext_vector_type(16)))float;
using u32x4=__attribute__((ext_vector_type(4)))unsigned;
constexpr int D=64,PQ=1536,PO=1024,SEQR=8192,MROW0=32768;
constexpr int NW=8,QBLK=32,QB=QBLK*NW,KVBLK=64;
__device__ __forceinline__ int crow(int r,int hi){return (r&3)+8*(r>>2)+4*hi;}
#define SBAR() __builtin_amdgcn_sched_barrier(0)
__device__ __forceinline__ void cmask(f32x16&p0,f32x16&p1,int jb,int hi){
  const float NEG=-INFINITY;
  #pragma unroll
  for(int r=0;r<16;++r){int kv=crow(r,hi); if(jb==1||kv>=16)p0[r]=NEG; p1[r]=NEG;}
}

constexpr int NSLOT=3, SLOTB=8192;
constexpr int LDS_K=0, LDS_V=NSLOT*SLOTB, LDS_WS=2*NSLOT*SLOTB, LDS_OST=LDS_WS+NW*64*4, LDS_BYTES=LDS_OST+NW*4096;
constexpr float C2=0.125f*1.4426950408889634f;
__device__ __forceinline__ void glds16(const void*gsrc,unsigned lds_dst){unsigned keep;
  asm volatile("s_mov_b32 %0, m0\n\ts_mov_b32 m0, %2\n\ts_nop 0\n\tglobal_load_lds_dwordx4 %1, off\n\ts_mov_b32 m0, %0":"=&s"(keep):"v"(gsrc),"s"(lds_dst):"memory");}
__device__ __forceinline__ float max3f(float a,float b,float c){float r;asm("v_max3_f32 %0, %1, %2, %3":"=v"(r):"v"(a),"v"(b),"v"(c));return r;}
__device__ __forceinline__ float max2f(float a,float b){float r;asm("v_max_f32_e32 %0, %1, %2":"=v"(r):"v"(a),"v"(b));return r;}
__device__ __forceinline__ float fadd_s(float a,float b){float r;asm("v_add_f32_e32 %0, %1, %2":"=v"(r):"v"(a),"v"(b));return r;}
__device__ __forceinline__ float fsub_s(float a,float b){float r;asm("v_sub_f32_e32 %0, %1, %2":"=v"(r):"v"(a),"v"(b));return r;}
typedef float f32x2_t __attribute__((ext_vector_type(2))); typedef __bf16 bf16x2_t __attribute__((ext_vector_type(2)));
__device__ __forceinline__ unsigned cvtpk_s(float lo,float hi){f32x2_t v={lo,hi};bf16x2_t b=__builtin_convertvector(v,bf16x2_t);return __builtin_bit_cast(unsigned,b);}
#define WAIT_BAR(N) asm volatile("s_waitcnt vmcnt(" #N ") lgkmcnt(0)\n\ts_barrier":::"memory")

__device__ __forceinline__ void qkt(f32x16&p0,f32x16&p1,const char*Kslot,const bf16x8*qr,const f32x16&negm,int r32,int hi){
  const char*kb=Kslot+hi*1024+r32*16;
  #pragma unroll
  for(int d0=0;d0<4;++d0){
    const bf16x8 b0=*reinterpret_cast<const bf16x8*>(kb+d0*2048);
    const bf16x8 b1=*reinterpret_cast<const bf16x8*>(kb+d0*2048+512);
    if(d0==0){p0=__builtin_amdgcn_mfma_f32_32x32x16_bf16(b0,qr[0],negm,0,0,0);p1=__builtin_amdgcn_mfma_f32_32x32x16_bf16(b1,qr[0],negm,0,0,0);}
    else{p0=__builtin_amdgcn_mfma_f32_32x32x16_bf16(b0,qr[d0],p0,0,0,0);p1=__builtin_amdgcn_mfma_f32_32x32x16_bf16(b1,qr[d0],p1,0,0,0);}}
}
typedef __attribute__((address_space(3))) const char* lds_cptr;
typedef short v4i16_t __attribute__((ext_vector_type(4)));
__device__ __forceinline__ void kload8(bf16x8*kf,lds_cptr kp){
  kf[0]=*(const __attribute__((address_space(3))) bf16x8*)(kp);      kf[1]=*(const __attribute__((address_space(3))) bf16x8*)(kp+512);
  kf[2]=*(const __attribute__((address_space(3))) bf16x8*)(kp+2048); kf[3]=*(const __attribute__((address_space(3))) bf16x8*)(kp+2560);
  kf[4]=*(const __attribute__((address_space(3))) bf16x8*)(kp+4096); kf[5]=*(const __attribute__((address_space(3))) bf16x8*)(kp+4608);
  kf[6]=*(const __attribute__((address_space(3))) bf16x8*)(kp+6144); kf[7]=*(const __attribute__((address_space(3))) bf16x8*)(kp+6656);
}
__device__ __forceinline__ void kload2(bf16x8*kf,lds_cptr kp,int j){ kf[2*j]=*(const __attribute__((address_space(3))) bf16x8*)(kp+j*2048); kf[2*j+1]=*(const __attribute__((address_space(3))) bf16x8*)(kp+j*2048+512); }
__device__ __forceinline__ s16x4 vtr(lds_cptr p){ return __builtin_bit_cast(s16x4,__builtin_amdgcn_ds_read_tr16_b64_v4i16((__attribute__((address_space(3))) v4i16_t*)p)); }
__device__ __forceinline__ float rowmax(const f32x16&p0,const f32x16&p1){
  float a=max3f(p0[0],p0[1],p1[0]),b=max3f(p0[2],p0[3],p1[1]);a=max3f(a,p1[2],p1[3]);
  #pragma unroll
  for(int r=4;r<16;r+=4){a=max3f(a,p0[r],p0[r+1]);b=max3f(b,p0[r+2],p0[r+3]);a=max3f(a,p1[r],p1[r+1]);b=max3f(b,p1[r+2],p1[r+3]);}
  const float m=max2f(a,b);
  auto rr=__builtin_amdgcn_permlane32_swap(__float_as_uint(m),__float_as_uint(m),false,false);
  return max2f(__uint_as_float(rr[0]),__uint_as_float(rr[1]));
}
__device__ __forceinline__ void pv(f32x16*o,int vb,bf16x8 pa0,bf16x8 pa1,bf16x8 pa2,bf16x8 pa3){
  #pragma unroll
  for(int d0=0;d0<2;++d0){s16x4 lo[4],hi[4];
    #pragma unroll
    for(int ks=0;ks<4;++ks){
      asm volatile("ds_read_b64_tr_b16 %0,%1 offset:%c2":"=&v"(lo[ks]):"v"(vb),"i"(d0*4096+ks*1024):"memory");
      asm volatile("ds_read_b64_tr_b16 %0,%1 offset:%c2":"=&v"(hi[ks]):"v"(vb),"i"(d0*4096+ks*1024+512):"memory");}
    asm volatile("s_waitcnt lgkmcnt(0)":::"memory");SBAR();
    #define PK(k) (bf16x8){lo[k][0],lo[k][1],lo[k][2],lo[k][3],hi[k][0],hi[k][1],hi[k][2],hi[k][3]}
    o[d0]=__builtin_amdgcn_mfma_f32_32x32x16_bf16(pa0,PK(0),o[d0],0,0,0);
    o[d0]=__builtin_amdgcn_mfma_f32_32x32x16_bf16(pa1,PK(1),o[d0],0,0,0);
    o[d0]=__builtin_amdgcn_mfma_f32_32x32x16_bf16(pa2,PK(2),o[d0],0,0,0);
    o[d0]=__builtin_amdgcn_mfma_f32_32x32x16_bf16(pa3,PK(3),o[d0],0,0,0);
    #undef PK
  }
}

#ifndef ATTN_STORE16
#define ATTN_STORE16(p,v) (*(u32x4*)(p)=(v))
#endif
template<int THRL> __device__ __forceinline__ void attn_unit(int b,int h,int qb,const bf16*QKV,bf16*O,char*shm){
  int tid_=threadIdx.x; asm volatile("":"+v"(tid_)); const int tid=tid_,lane=tid&63,r32=lane&31,hi=lane>>5; const int wid=__builtin_amdgcn_readfirstlane(tid>>6);
  const bool meta=(qb==32); const int kvh=h>>2;
  const long rowbase=(long)b*SEQR; const long metabase=(long)MROW0+b*16;
  const bf16*Qlane=meta? QKV+(metabase+(r32&15))*PQ+(h+(wid&1)*2+(r32>>4))*D : QKV+(rowbase+qb*QB+wid*QBLK+r32)*PQ+h*D;
  const bf16*Kh=QKV+1024+kvh*D,*Vh=QKV+1280+kvh*D;
  #define TROW(t) ((t)<128?rowbase+(long)(t)*KVBLK:metabase)
  const unsigned lds0=(unsigned)(uintptr_t)shm;
  float*wsf=(float*)(shm+LDS_WS)+wid*64;
  const bf16*ksrc=Kh+(long)lane*PQ+wid*8;
  const bf16*vsrc=Vh+(long)(16*(wid&3)+(lane>>2))*PQ+(wid>>2)*32+(lane&3)*8;
  const unsigned kdst=lds0+LDS_K+wid*1024, vdst=lds0+LDS_V+wid*1024;
  #define DMA_K(t,slot) glds16(ksrc+TROW(t)*PQ,(unsigned)__builtin_amdgcn_readfirstlane(kdst+(slot)))
  #define DMA_V(t,slot) glds16(vsrc+TROW(t)*PQ,(unsigned)__builtin_amdgcn_readfirstlane(vdst+(slot)))
  const int vb0=(int)(lds0+LDS_V)+((lane>>4)&1)*32+(lane&3)*8+(4*hi+((lane&15)>>2))*64;
  const char*Kbase=shm+LDS_K; bf16x8 kf[8];
  const lds_cptr shm3=(lds_cptr)shm; const lds_cptr kp0=shm3+LDS_K+hi*1024+r32*16; const lds_cptr vp0=shm3+LDS_V+((lane>>4)&1)*32+(lane&3)*8+(4*hi+((lane&15)>>2))*64;
  constexpr int NT=130;
  DMA_K(0,0);DMA_V(0,0);DMA_K(1,SLOTB);
  bf16x8 qr[4];
  #pragma unroll
  for(int d0=0;d0<4;++d0)qr[d0]=*reinterpret_cast<const bf16x8*>(&Qlane[d0*16+hi*8]);
  float mhat=0.f,l_reg=0.f;f32x16 o[2];o[0]=f32x16{};o[1]=f32x16{};f32x16 negm=f32x16{};asm volatile("":"+v"(negm));
  #define CMASK(P0,P1,t) do{int jb_=(t)-(NT-2); if(jb_>=0)cmask(P0,P1,jb_,hi);}while(0)
  bool resc=false;
  #define START(P0,P1) do{ const float rm=rowmax(P0,P1); resc=false; \
    { const float dl=rm; mhat=fadd_s(mhat,dl); \
      _Pragma("unroll") for(int r=0;r<16;++r){P0[r]=fsub_s(P0[r],dl);P1[r]=fsub_s(P1[r],dl);} \
      _Pragma("unroll") for(int r=0;r<16;++r)negm[r]=-mhat; asm volatile("":"+v"(negm)); } \
    _Pragma("unroll") for(int r=0;r<16;++r)P0[r]=__builtin_amdgcn_exp2f(P0[r]); }while(0)
  #define RESC() do{ if(resc){ asm volatile("s_waitcnt lgkmcnt(0)":::"memory"); \
      _Pragma("unroll") for(int d_=0;d_<2;++d_) _Pragma("unroll") for(int r=0;r<16;++r)o[d_][r]*=wsf[crow(r,hi)]; } }while(0)
  f32x16 pA0,pA1,pB0,pB1;
  int sl_prev=0,sl_cur=0,sl_next=SLOTB;
  #define ROT() do{sl_prev=sl_cur;sl_cur=sl_next;sl_next=(sl_next==(NSLOT-1)*SLOTB)?0:sl_next+SLOTB;}while(0)
  DMA_K(2,2*SLOTB);
  WAIT_BAR(3);
  qkt(pA0,pA1,Kbase,qr,negm,r32,hi);asm volatile("s_nop 15\n\ts_nop 7":"+v"(pA0),"+v"(pA1));CMASK(pA0,pA1,0);
  START(pA0,pA1);
  _Pragma("unroll") for(int r=0;r<16;++r)pA1[r]=__builtin_amdgcn_exp2f(pA1[r]);
  WAIT_BAR(0);
  DMA_K(3,0);DMA_V(1,SLOTB);
  ROT();
  kload8(kf,kp0+sl_cur);
  WAIT_BAR(2);
  s16x4 vlo[8],vhi[8]; u32x4 pw0,pw1,pw2,pw3;
  #define PKW(P,B) cvtpk_s(P[B],P[B+1])
  #define PAF(k) __builtin_bit_cast(bf16x8,pw##k)
  #define VFR(i) (bf16x8){vlo[i][0],vlo[i][1],vlo[i][2],vlo[i][3],vhi[i][0],vhi[i][1],vhi[i][2],vhi[i][3]}
  #define PIN(x) asm volatile("":"+v"(x))
  #define MX3(a,b,c) __builtin_fmaxf(__builtin_fmaxf((a),(b)),(c))
  #define GAPA(MF,A0,A1,A2,A3,W0,W1,PW) do{ MF; sacc+=A0; sacc+=A1; sacc+=A2; sacc+=A3; PIN(sacc); W0; W1; PIN(PW); SBAR(); }while(0)
  #define EX(v) __builtin_amdgcn_exp2f(v)
  #define GAPB(MF,X,B) do{ MF; X[B]=EX(X[B]); X[B+1]=EX(X[B+1]); X[B+2]=EX(X[B+2]); X[B+3]=EX(X[B+3]); PIN(X); SBAR(); }while(0)
  #define VRD(i) do{ vlo[i]=vtr(vp_+(((i)>>2)*4096+((i)&3)*1024)); vhi[i]=vtr(vp_+(((i)>>2)*4096+((i)&3)*1024+512)); }while(0)
  #define KRD(G,j) do{ if(G){ kload2(kf,kp0+sl_next,j); SBAR(); } }while(0)
  #define STEP(C0,C1,P0,P1,t,GK,GV,GL) do{ SBAR(); \
    const lds_cptr vp_=vp0+sl_prev; \
    VRD(0); SBAR(); float sacc=(P0[0]+P0[1]); \
    GAPA(C0=__builtin_amdgcn_mfma_f32_32x32x16_bf16(kf[0],qr[0],negm,0,0,0), P0[2],P0[3],P0[4],P0[5],     pw0[0]=PKW(P0,0), pw0[1]=PKW(P0,2), pw0); \
    VRD(4); SBAR(); GAPA(C1=__builtin_amdgcn_mfma_f32_32x32x16_bf16(kf[1],qr[0],negm,0,0,0), P0[6],P0[7],P0[8],P0[9],     pw0[2]=PKW(P0,4), pw0[3]=PKW(P0,6), pw0); \
    VRD(1); SBAR(); GAPA(C0=__builtin_amdgcn_mfma_f32_32x32x16_bf16(kf[2],qr[1],C0,0,0,0),   P0[10],P0[11],P0[12],P0[13], pw1[0]=PKW(P0,8), pw1[1]=PKW(P0,10), pw1); \
    VRD(5); SBAR(); GAPA(C1=__builtin_amdgcn_mfma_f32_32x32x16_bf16(kf[3],qr[1],C1,0,0,0),   P0[14],P0[15],P1[0],P1[1],   pw1[2]=PKW(P0,12),pw1[3]=PKW(P0,14), pw1); \
    VRD(2); SBAR(); GAPA(C0=__builtin_amdgcn_mfma_f32_32x32x16_bf16(kf[4],qr[2],C0,0,0,0),   P1[2],P1[3],P1[4],P1[5],     pw2[0]=PKW(P1,0), pw2[1]=PKW(P1,2), pw2); \
    VRD(6); SBAR(); GAPA(C1=__builtin_amdgcn_mfma_f32_32x32x16_bf16(kf[5],qr[2],C1,0,0,0),   P1[6],P1[7],P1[8],P1[9],     pw2[2]=PKW(P1,4), pw2[3]=PKW(P1,6), pw2); \
    VRD(3); SBAR(); GAPA(C0=__builtin_amdgcn_mfma_f32_32x32x16_bf16(kf[6],qr[3],C0,0,0,0),   P1[10],P1[11],P1[12],P1[13], pw3[0]=PKW(P1,8), pw3[1]=PKW(P1,10), pw3); \
    VRD(7); SBAR(); GAPA(C1=__builtin_amdgcn_mfma_f32_32x32x16_bf16(kf[7],qr[3],C1,0,0,0),   P1[14],P1[15],0.f,0.f,       pw3[2]=PKW(P1,12),pw3[3]=PKW(P1,14), pw3); \
    l_reg+=sacc; \
    if(GK){DMA_K((t)+3,sl_cur);} if(GV){DMA_V((t)+1,sl_next);} \
    CMASK(C0,C1,t); \
    { float a=MX3(C0[0],C0[1],C1[0]),b=MX3(C0[2],C0[3],C1[1]); a=MX3(a,C1[2],C1[3]); \
      _Pragma("unroll") for(int r=4;r<16;r+=4){a=MX3(a,C0[r],C0[r+1]);b=MX3(b,C0[r+2],C0[r+3]);a=MX3(a,C1[r],C1[r+1]);b=MX3(b,C1[r+2],C1[r+3]);} \
      float rm=__builtin_fmaxf(a,b); { auto rr=__builtin_amdgcn_permlane32_swap(__float_as_uint(rm),__float_as_uint(rm),false,false); rm=__builtin_fmaxf(__uint_as_float(rr[0]),__uint_as_float(rr[1])); } \
      resc=false; \
      if(__builtin_expect(__any(rm>(float)THRL),0)){ const float dl=__builtin_fmaxf(rm,0.f); mhat+=dl; \
        _Pragma("unroll") for(int r=0;r<16;++r){C0[r]-=dl;C1[r]-=dl;} \
        _Pragma("unroll") for(int r=0;r<16;++r)negm[r]=-mhat; asm volatile("":"+v"(negm)); \
        const float f=__builtin_amdgcn_exp2f(-dl); l_reg*=f; if(hi==0)wsf[r32]=f; resc=true; } } \
    SBAR(); \
    GAPB(o[0]=__builtin_amdgcn_mfma_f32_32x32x16_bf16(PAF(0),VFR(0),o[0],0,0,0), C0,0); \
    GAPB(o[1]=__builtin_amdgcn_mfma_f32_32x32x16_bf16(PAF(0),VFR(4),o[1],0,0,0), C0,4); \
    KRD(GL,0); GAPB(o[0]=__builtin_amdgcn_mfma_f32_32x32x16_bf16(PAF(1),VFR(1),o[0],0,0,0), C0,8); \
    KRD(GL,1); GAPB(o[1]=__builtin_amdgcn_mfma_f32_32x32x16_bf16(PAF(1),VFR(5),o[1],0,0,0), C0,12); \
    KRD(GL,2); GAPB(o[0]=__builtin_amdgcn_mfma_f32_32x32x16_bf16(PAF(2),VFR(2),o[0],0,0,0), C1,0); \
    KRD(GL,3); GAPB(o[1]=__builtin_amdgcn_mfma_f32_32x32x16_bf16(PAF(2),VFR(6),o[1],0,0,0), C1,4); \
    GAPB(o[0]=__builtin_amdgcn_mfma_f32_32x32x16_bf16(PAF(3),VFR(3),o[0],0,0,0), C1,8); \
    GAPB(o[1]=__builtin_amdgcn_mfma_f32_32x32x16_bf16(PAF(3),VFR(7),o[1],0,0,0), C1,12); \
    }while(0)
  int t=1;
  #undef CMASK
  #define CMASK(P0,P1,t) do{}while(0)
  for(;t+5<NT;t+=2){
    STEP(pB0,pB1,pA0,pA1,t,true,true,true);     WAIT_BAR(2); RESC(); ROT();
    STEP(pA0,pA1,pB0,pB1,t+1,true,true,true);   WAIT_BAR(2); RESC(); ROT();
  }
  #undef CMASK
  #define CMASK(P0,P1,t) do{int jb_=(t)-(NT-2); if(jb_>=0)cmask(P0,P1,jb_,hi);}while(0)
  #define ENDW(tt) do{ if((tt)+3<NT){WAIT_BAR(2);} else if((tt)+2<NT){WAIT_BAR(1);} else {WAIT_BAR(0);} }while(0)
  for(;t+1<NT;t+=2){
    STEP(pB0,pB1,pA0,pA1,t,(t+3<NT),(t+1<NT),(t+1<NT));       ENDW(t);   RESC(); ROT();
    STEP(pA0,pA1,pB0,pB1,t+1,(t+4<NT),(t+2<NT),(t+2<NT));     ENDW(t+1); RESC(); ROT();
  }
  STEP(pB0,pB1,pA0,pA1,NT-1,false,false,false); RESC();
  { float sacc=pB0[0]+pB0[1]; _Pragma("unroll") for(int r=2;r<16;++r)sacc+=pB0[r]; _Pragma("unroll") for(int r=0;r<16;++r)sacc+=pB1[r]; l_reg+=sacc;
    pw0=(u32x4){PKW(pB0,0),PKW(pB0,2),PKW(pB0,4),PKW(pB0,6)};pw1=(u32x4){PKW(pB0,8),PKW(pB0,10),PKW(pB0,12),PKW(pB0,14)};pw2=(u32x4){PKW(pB1,0),PKW(pB1,2),PKW(pB1,4),PKW(pB1,6)};pw3=(u32x4){PKW(pB1,8),PKW(pB1,10),PKW(pB1,12),PKW(pB1,14)};
    SBAR(); pv(o,vb0+sl_cur,PAF(0),PAF(1),PAF(2),PAF(3)); }
  #undef PKW
  #undef PAF
  #undef VFR
  #undef PIN
  #undef MX3
  #undef GAPA
  #undef GAPB
  #undef EX
  #undef VRD
  #undef KRD
  #undef STEP
  #undef ENDW
  {auto rr=__builtin_amdgcn_permlane32_swap(__float_as_uint(l_reg),__float_as_uint(l_reg),false,false);l_reg=__uint_as_float(rr[0])+__uint_as_float(rr[1]);}
  if(hi==0)wsf[32+r32]=l_reg;asm volatile("s_waitcnt lgkmcnt(0)":::"memory");
  float rli[16];
  #pragma unroll
  for(int r=0;r<16;++r)rli[r]=__builtin_amdgcn_rcpf(wsf[32+crow(r,hi)]);
  { bf16*stg=(bf16*)(shm+LDS_OST)+wid*2048;
    #pragma unroll
    for(int r=0;r<16;++r){const int orow=crow(r,hi);
      #pragma unroll
      for(int d0=0;d0<2;++d0)stg[orow*64+d0*32+r32]=__float2bfloat16(o[d0][r]*rli[r]);}
    asm volatile("s_waitcnt lgkmcnt(0)":::"memory");
    #pragma unroll
    for(int i=0;i<4;++i){const int row=i*8+(lane>>3),ch=lane&7; const u32x4 v=*(const u32x4*)(stg+row*64+ch*8);
      bf16*op=meta? O+(metabase+(row&15))*PO+(h+(wid&1)*2+(row>>4))*D+ch*8 : O+(rowbase+qb*QB+wid*QBLK+row)*PO+h*D+ch*8;
      if(!meta||wid<2) ATTN_STORE16(op,v);} }
  asm volatile("s_waitcnt lgkmcnt(0)\n\ts_barrier":::"memory");
  #undef DMA_K
  #undef TROW
  #undef DMA_V
  #undef CMASK
  #undef START
  #undef RESC
  #undef ROT
}
constexpr int ATTN_LDS_BYTES=LDS_BYTES;
#undef SBAR
#undef WAIT_BAR
}
#define LAS __attribute__((address_space(3)))
typedef unsigned short bf16_t;
typedef short bf16x8 __attribute__((ext_vector_type(8)));
typedef float f32x4 __attribute__((ext_vector_type(4)));
typedef float f32x2 __attribute__((ext_vector_type(2)));
typedef unsigned u32x2 __attribute__((ext_vector_type(2)));
typedef unsigned u32x4 __attribute__((ext_vector_type(4)));
typedef __bf16 bf16x2_t __attribute__((ext_vector_type(2)));

constexpr int NTHR = 512, NWAVES = 8;
constexpr int DMODEL = 1024, MR = 32768, NMROWS = 64, MP = 33024, SEQL = 8192, FFH = 2816;
constexpr float RMS_EPS = 1e-6f;
constexpr int LDS_BYTES = 147456;
constexpr size_t MiB = 1u << 20;
constexpr size_t OFF_W_AQKV = 0;
constexpr size_t OFF_W_AO   = 12 * MiB;
constexpr size_t OFF_W_BQKV = 16 * MiB;
constexpr size_t OFF_W_BO   = 19 * MiB;
constexpr size_t OFF_W_CIN  = 21 * MiB;
constexpr size_t OFF_W_CO   = 28 * MiB;
constexpr size_t OFF_W13    = 30 * MiB;
constexpr size_t OFF_W2     = 74 * MiB;
constexpr size_t OFF_HB     = 96 * MiB;
constexpr size_t OFF_AO     = 161 * MiB;
constexpr size_t OFF_QKV    = 226 * MiB;
constexpr size_t OFF_VT     = OFF_QKV + 129 * MiB;
constexpr size_t OFF_HX     = 436 * MiB;
constexpr size_t OFF_SS     = 444 * MiB;
constexpr size_t OFF_GATES  = 439 * MiB;
constexpr size_t OFF_ROPE   = 442 * MiB;
constexpr size_t WS_END     = 464 * MiB;

struct Args { const float* in[20]; float* out; unsigned char* ws; int ph_lo, ph_hi; };

__device__ __forceinline__ int opaque_tid() { int t = threadIdx.x; asm volatile("" : "+v"(t)); return t; }
__device__ __forceinline__ unsigned pk2(float lo, float hi) { f32x2 v = {lo, hi}; bf16x2_t b = __builtin_convertvector(v, bf16x2_t); return __builtin_bit_cast(unsigned, b); }
__device__ __forceinline__ float bf2f(unsigned short v) { return __uint_as_float(((unsigned)v) << 16); }
__device__ __forceinline__ float bflo(unsigned w) { return __uint_as_float(w << 16); }
__device__ __forceinline__ float bfhi(unsigned w) { return __uint_as_float(w & 0xffff0000u); }
__device__ __forceinline__ f32x4 mfma16(bf16x8 a, bf16x8 b, f32x4 c) { return __builtin_amdgcn_mfma_f32_16x16x32_bf16(a, b, c, 0, 0, 0); }
__device__ __forceinline__ float rstd_of(const float* p16) { const f32x4 a = *(const f32x4*)p16, b = *(const f32x4*)(p16 + 4), c = *(const f32x4*)(p16 + 8), d = *(const f32x4*)(p16 + 12);
    const float ss = (((a[0] + a[1]) + (a[2] + a[3])) + ((b[0] + b[1]) + (b[2] + b[3]))) + (((c[0] + c[1]) + (c[2] + c[3])) + ((d[0] + d[1]) + (d[2] + d[3])));
    return rsqrtf(ss * (1.0f / 1024.0f) + RMS_EPS); }

struct EpiScaleBf16 {
    static constexpr bool PERM = false, AFTER_DRAIN = false;
    bf16_t* O; int ldc; const float* ss; float* gates; int gate_pn;
    __device__ __forceinline__ void operator()(const pg8::f32x4 (&acc)[2][2][4][2], const pg8::Unit& u, int wr, int wc, int fr_, int fq_) const {
        int fr = fr_, fq = fq_; asm volatile("" : "+v"(fr), "+v"(fq));
#pragma unroll
        for (int ai = 0; ai < 2; ++ai)
#pragma unroll
            for (int m = 0; m < 4; ++m) {
                const int row = u.pm * 256 + ai * 128 + wr * 64 + m * 16 + fr;
                const float rs = rstd_of(ss + (size_t)row * 16);
                if (u.pn == gate_pn) {
                    if (wc == 0) { const pg8::f32x4 v = acc[ai][0][m][0] * rs; *(f32x4*)(gates + (size_t)row * 16 + 4 * fq) = (f32x4){v[0], v[1], v[2], v[3]}; }
                } else {
#pragma unroll
                    for (int bj = 0; bj < 2; ++bj)
#pragma unroll
                        for (int n = 0; n < 2; ++n) {
                            const int col = u.pn * 256 + bj * 128 + wc * 32 + n * 16 + 4 * fq;
                            const pg8::f32x4 v = acc[ai][bj][m][n] * rs;
                            u32x2 w; w.x = pk2(v[0], v[1]); w.y = pk2(v[2], v[3]);
                            *(u32x2*)(O + (size_t)row * ldc + col) = w;
                        }
                }
            }
    }
};
struct EpiScaleColBf16 {
    static constexpr bool PERM = false, AFTER_DRAIN = false;
    bf16_t* O; int ldc; const float* ss;
    __device__ __forceinline__ void operator()(const pg8::f32x4 (&acc)[2][2][4][2], const pg8::Unit& u, int wr, int wc, int fr_, int fq_) const {
        int fr = fr_, fq = fq_; asm volatile("" : "+v"(fr), "+v"(fq));
#pragma unroll
        for (int bj = 0; bj < 2; ++bj)
#pragma unroll
            for (int n = 0; n < 2; ++n) {
                const int col = u.pn * 256 + bj * 128 + wc * 32 + n * 16 + 4 * fq;
                pg8::f32x4 rs; rs[0] = rstd_of(ss + (size_t)col * 16); rs[1] = rstd_of(ss + (size_t)col * 16 + 16); rs[2] = rstd_of(ss + (size_t)col * 16 + 32); rs[3] = rstd_of(ss + (size_t)col * 16 + 48);
#pragma unroll
                for (int ai = 0; ai < 2; ++ai)
#pragma unroll
                    for (int m = 0; m < 4; ++m) {
                        const int row = u.pm * 256 + ai * 128 + wr * 64 + m * 16 + fr;
                        const pg8::f32x4 v = acc[ai][bj][m][n] * rs;
                        u32x2 w; w.x = pk2(v[0], v[1]); w.y = pk2(v[2], v[3]);
                        *(u32x2*)(O + (size_t)row * ldc + col) = w;
                    }
            }
    }
};
struct EpiResid {
    static constexpr bool PERM = false, AFTER_DRAIN = false;
    float* Hmain; float* Hx; bf16_t* HB; float* ssn;
    __device__ __forceinline__ void operator()(const pg8::f32x4 (&acc)[2][2][4][2], const pg8::Unit& u, int wr, int wc, int fr_, int fq_) const {
        int fr = fr_, fq = fq_; asm volatile("" : "+v"(fr), "+v"(fq));
        float* Hb = (u.pm < 128) ? Hmain + (size_t)u.pm * 256 * 1024 : Hx;
#pragma unroll
        for (int ai = 0; ai < 2; ++ai)
#pragma unroll
            for (int m = 0; m < 4; ++m) {
                const int rl = ai * 128 + wr * 64 + m * 16 + fr; const int row = u.pm * 256 + rl;
                float sq = 0.f;
#pragma unroll
                for (int bj = 0; bj < 2; ++bj)
#pragma unroll
                    for (int n = 0; n < 2; ++n) {
                        const int col = u.pn * 256 + bj * 128 + wc * 32 + n * 16 + 4 * fq;
                        f32x4* hp = (f32x4*)(Hb + (size_t)rl * 1024 + col);
                        f32x4 hv = *hp; const pg8::f32x4 a = acc[ai][bj][m][n];
                        hv[0] += a[0]; hv[1] += a[1]; hv[2] += a[2]; hv[3] += a[3];
                        *hp = hv;
                        sq += (hv[0] * hv[0] + hv[1] * hv[1]) + (hv[2] * hv[2] + hv[3] * hv[3]);
                        u32x2 w; w.x = pk2(hv[0], hv[1]); w.y = pk2(hv[2], hv[3]);
                        *(u32x2*)(HB + (size_t)row * 1024 + col) = w;
                    }
                sq += __shfl_xor(sq, 16); sq += __shfl_xor(sq, 32);
                if (fq == 0) ssn[(size_t)row * 16 + u.pn * 4 + wc] = sq;
            }
    }
};
struct EpiSwiglu {
    static constexpr bool PERM = false, AFTER_DRAIN = false;
    bf16_t* O; const float* ss;
    __device__ __forceinline__ void operator()(const pg8::f32x4 (&acc)[2][2][4][2], const pg8::Unit& u, int wr, int wc, int fr_, int fq_) const {
        int fr = fr_, fq = fq_; asm volatile("" : "+v"(fr), "+v"(fq));
#pragma unroll
        for (int ai = 0; ai < 2; ++ai)
#pragma unroll
            for (int m = 0; m < 4; ++m) {
                const int row = u.pm * 256 + ai * 128 + wr * 64 + m * 16 + fr;
                const float rs = rstd_of(ss + (size_t)row * 16);
#pragma unroll
                for (int bj = 0; bj < 2; ++bj)
#pragma unroll
                    for (int n = 0; n < 2; ++n) {
                        const int col = u.pn * 256 + bj * 128 + wc * 32 + n * 16 + 4 * fq;
                        const pg8::f32x4 v = acc[ai][bj][m][n] * rs;
                        const float h0 = v[0] / (1.f + __expf(-v[0])) * v[1];
                        const float h1 = v[2] / (1.f + __expf(-v[2])) * v[3];
                        *(unsigned*)(O + (size_t)row * FFH + (col >> 1)) = pk2(h0, h1);
                    }
            }
    }
};
__device__ __forceinline__ float wave_sum(float v) {
#pragma unroll
    for (int o = 1; o < 64; o <<= 1) v += __shfl_xor(v, o);
    return v;
}
__device__ __forceinline__ void transpose_item(const float* W, int Npitch, int K, int nblk, const float* g, bf16_t* WT, int row_off, int row_mul, LAS float* scr, int item, int lane) {
    const int kb = item / nblk, nb = item % nblk, k0 = 64 * kb, n0 = 32 * nb;
#pragma unroll 8
    for (int i = 0; i < 32; ++i) { const int kk = 2 * i + (lane >> 5); const float gv = g ? g[k0 + kk] : 1.f; scr[kk * 33 + (lane & 31)] = W[(size_t)(k0 + kk) * Npitch + n0 + (lane & 31)] * gv; }
    asm volatile("s_waitcnt lgkmcnt(0)" ::: "memory");
    const int c = lane & 7;
#pragma unroll
    for (int j = 0; j < 4; ++j) { const int n = (lane >> 3) + 8 * j; const LAS float* s = scr + (8 * c) * 33 + n;
        u32x4 o; o.x = pk2(s[0 * 33], s[1 * 33]); o.y = pk2(s[2 * 33], s[3 * 33]); o.z = pk2(s[4 * 33], s[5 * 33]); o.w = pk2(s[6 * 33], s[7 * 33]);
        *(u32x4*)(WT + (size_t)(row_off + (n0 + n) * row_mul) * K + k0 + 8 * c) = o; }
    asm volatile("s_waitcnt lgkmcnt(0)" ::: "memory");
}
__device__ __forceinline__ void prologue_phase(const Args& a, LAS unsigned char* lds) {
    const int tid = opaque_tid(), lane = tid & 63, wave = tid >> 6;
    const int gw = blockIdx.x * NWAVES + wave, NGW = gridDim.x * NWAVES;
    LAS float* scr = (LAS float*)(lds + wave * 16384);
    unsigned char* ws = a.ws;
    const float* nmix = a.in[2]; const float* nffn = a.in[3];
    constexpr int I_AQKV = 16 * 96, I_SQ = 16 * 32, I_BQKV = 16 * 48, I_CIN = 16 * 96, I_W1 = 16 * 88, I_W2 = 44 * 32, I_FFN = 2 * I_W1 + I_W2;
    constexpr int NITEMS = 2 * I_AQKV + 2 * I_SQ + I_BQKV + I_SQ + I_CIN + I_SQ + 4 * I_FFN;
    for (int it = gw; it < NITEMS; it += NGW) {
        int r = it;
#define TRI(NIT, W, NP, KK, NBLK, G, WT, RO, RM) if (r < (NIT)) { transpose_item(W, NP, KK, NBLK, G, (bf16_t*)(WT), RO, RM, scr, r, lane); continue; } r -= (NIT);
        TRI(I_AQKV, a.in[5], 3072, 1024, 96, nmix, ws + OFF_W_AQKV, 0, 1)
        TRI(I_AQKV, a.in[5] + (size_t)1024 * 3072, 3072, 1024, 96, nmix + 3 * 1024, ws + OFF_W_AQKV + 6 * MiB, 0, 1)
        TRI(I_SQ, a.in[8], 1024, 1024, 32, nullptr, ws + OFF_W_AO, 0, 1)
        TRI(I_SQ, a.in[8] + (size_t)1024 * 1024, 1024, 1024, 32, nullptr, ws + OFF_W_AO + 2 * MiB, 0, 1)
        TRI(I_BQKV, a.in[9], 1536, 1024, 48, nmix + 1024, ws + OFF_W_BQKV, 0, 1)
        TRI(I_SQ, a.in[12], 1024, 1024, 32, nullptr, ws + OFF_W_BO, 0, 1)
        TRI(I_CIN, a.in[13], 3088, 1024, 96, nmix + 2048, ws + OFF_W_CIN, 0, 1)
        TRI(I_SQ, a.in[16], 1024, 1024, 32, nullptr, ws + OFF_W_CO, 0, 1)
        { const int li = r / I_FFN; r -= li * I_FFN;
          TRI(I_W1, a.in[17] + (size_t)li * 1024 * FFH, FFH, 1024, 88, nffn + li * 1024, ws + OFF_W13 + (size_t)li * 11 * MiB, 0, 2)
          TRI(I_W1, a.in[18] + (size_t)li * 1024 * FFH, FFH, 1024, 88, nffn + li * 1024, ws + OFF_W13 + (size_t)li * 11 * MiB, 1, 2)
          transpose_item(a.in[19] + (size_t)li * FFH * 1024, 1024, FFH, 32, nullptr, (bf16_t*)(ws + OFF_W2 + (size_t)li * 11 * MiB / 2), 0, 1, scr, r, lane); }
#undef TRI
    }
    const int gt = blockIdx.x * NTHR + tid, NGT = gridDim.x * NTHR;
    { bf16_t* wc = (bf16_t*)(ws + OFF_W_CIN); const float* W = a.in[13]; const float* g = nmix + 2048;
      for (int i = gt; i < 256 * 1024; i += NGT) { const int n = 3072 + (i >> 10), k = i & 1023; const float v = (n < 3088) ? W[(size_t)k * 3088 + n] * g[k] : 0.f; wc[(size_t)n * 1024 + k] = (bf16_t)(pk2(v, 0.f) & 0xffffu); } }
    { f32x2* tab = (f32x2*)(ws + OFF_ROPE);
      for (int i = gt; i < 128 * 16; i += NGT) { const int pos = i >> 4, fi = i & 15; const float freq = 1.0f / powf(10000.0f, (float)fi * (1.0f / 16.0f)); const float ang = (float)pos * freq;
          const double tw = 6.283185307179586476925; const double rr = (double)ang - tw * rint((double)ang / tw); const float rf = (float)rr;
          tab[i] = (f32x2){__cosf(rf), __sinf(rf)}; } }
    { float* ss0 = (float*)(ws + OFF_SS); bf16_t* HB = (bf16_t*)(ws + OFF_HB); bf16_t* AO = (bf16_t*)(ws + OFF_AO); float* HX = (float*)(ws + OFF_HX);
      for (int row = gw; row < MP; row += NGW) {
          const bool real = row < MR, meta = (!real) && row < MR + NMROWS;
          const float* src = real ? a.in[0] + (size_t)row * 1024 : a.in[1] + (size_t)((row - MR) & 15) * 1024;
          float* dst = real ? a.out + (size_t)row * 1024 : HX + (size_t)(row - MR) * 1024;
          float s = 0.f;
#pragma unroll
          for (int j = 0; j < 4; ++j) { f32x4 v = (f32x4){0.f, 0.f, 0.f, 0.f}; if (real || meta) v = *(const f32x4*)(src + 256 * j + 4 * lane);
              *(f32x4*)(dst + 256 * j + 4 * lane) = v; s += (v[0] * v[0] + v[1] * v[1]) + (v[2] * v[2] + v[3] * v[3]);
              u32x2 w; w.x = pk2(v[0], v[1]); w.y = pk2(v[2], v[3]); *(u32x2*)(HB + (size_t)row * 1024 + 256 * j + 4 * lane) = w;
              if (!real && !meta) *(u32x2*)(AO + (size_t)row * 1024 + 256 * j + 4 * lane) = (u32x2){0u, 0u}; }
          s = wave_sum(s); if (lane < 16) ss0[(size_t)row * 16 + lane] = (lane == 0) ? s : 0.f; } }
}

template <bool META>
__device__ __forceinline__ void na_unit(const bf16_t* __restrict__ QK, const bf16_t* __restrict__ VT, const float* __restrict__ relb, const float* __restrict__ metab, bf16_t* __restrict__ AO, int b, int h, int r, int j, int lane) {
    const int l16 = lane & 15, g = lane >> 4;
    const int qcol = META ? 0 : 16 * j + l16;
    const long mrow0 = (long)MR + b * 16;
    const long qrow = META ? mrow0 + l16 : (long)b * SEQL + r * 64 + qcol;
    const bf16_t* qp = QK + qrow * 2048 + h * 64 + 8 * g;
    const bf16x8 qf0 = *(const bf16x8*)qp, qf1 = *(const bf16x8*)(qp + 32);
    f32x4 sm;
    { const bf16_t* kp = QK + (mrow0 + l16) * 2048 + 1024 + h * 64 + 8 * g;
      const bf16x8 k0 = *(const bf16x8*)kp, k1 = *(const bf16x8*)(kp + 32);
      f32x4 acc = (f32x4){0.f, 0.f, 0.f, 0.f}; acc = mfma16(k0, qf0, acc); acc = mfma16(k1, qf1, acc);
#pragma unroll
      for (int e = 0; e < 4; ++e) sm[e] = acc[e] * 0.125f + metab[4 * g + e]; }
    float mx = fmaxf(fmaxf(sm[0], sm[1]), fmaxf(sm[2], sm[3]));
    f32x4 s[8][2];
    const int kstart = (j == 0) ? 0 : (j == 1) ? 8 : (j == 2) ? 24 : 32;
    const int rs = min(max(r - 4, 0), 120);
    if (!META) {
        const int qs = min(max(qcol - 8, 0), 48);
        const int kc0 = kstart + 8 * (l16 >> 2) + (l16 & 3);
#pragma unroll
        for (int i = 0; i < 8; ++i) {
            const long krow = (long)b * SEQL + (rs + i) * 64;
            const bf16_t* kp0 = QK + (krow + kc0) * 2048 + 1024 + h * 64 + 8 * g;
            const bf16_t* kp1 = kp0 + 4 * 2048;
            f32x4 a0 = (f32x4){0.f, 0.f, 0.f, 0.f}, a1 = (f32x4){0.f, 0.f, 0.f, 0.f};
            a0 = mfma16(*(const bf16x8*)kp0, qf0, a0); a0 = mfma16(*(const bf16x8*)(kp0 + 32), qf1, a0);
            a1 = mfma16(*(const bf16x8*)kp1, qf0, a1); a1 = mfma16(*(const bf16x8*)(kp1 + 32), qf1, a1);
            const float* rb = relb + (rs + i - r + 7) * 31;
#pragma unroll
            for (int e = 0; e < 4; ++e) {
                const int kc = kstart + 8 * g + e, kd = kc + 4;
                const bool v0 = (kc >= qs) && (kc < qs + 16), v1 = (kd >= qs) && (kd < qs + 16);
                const int dc0 = min(max(kc - qcol + 15, 0), 30), dc1 = min(max(kd - qcol + 15, 0), 30);
                const float b0 = rb[dc0], b1 = rb[dc1];
                s[i][0][e] = v0 ? a0[e] * 0.125f + b0 : -INFINITY;
                s[i][1][e] = v1 ? a1[e] * 0.125f + b1 : -INFINITY;
                mx = fmaxf(mx, fmaxf(s[i][0][e], s[i][1][e]));
            }
        }
    }
    mx = fmaxf(mx, __shfl_xor(mx, 16)); mx = fmaxf(mx, __shfl_xor(mx, 32));
    float sum = 0.f;
#pragma unroll
    for (int e = 0; e < 4; ++e) { sm[e] = __expf(sm[e] - mx); sum += sm[e]; }
    if (!META) {
#pragma unroll
        for (int i = 0; i < 8; ++i)
#pragma unroll
            for (int e = 0; e < 4; ++e) { s[i][0][e] = __expf(s[i][0][e] - mx); s[i][1][e] = __expf(s[i][1][e] - mx); sum += s[i][0][e] + s[i][1][e]; }
    }
    sum += __shfl_xor(sum, 16); sum += __shfl_xor(sum, 32);
    const float inv = 1.0f / sum;
    f32x4 o[4];
#pragma unroll
    for (int dt = 0; dt < 4; ++dt) o[dt] = (f32x4){0.f, 0.f, 0.f, 0.f};
    if (!META) {
#pragma unroll
        for (int i = 0; i < 8; ++i) {
            u32x4 pw; pw.x = pk2(s[i][0][0] * inv, s[i][0][1] * inv); pw.y = pk2(s[i][0][2] * inv, s[i][0][3] * inv); pw.z = pk2(s[i][1][0] * inv, s[i][1][1] * inv); pw.w = pk2(s[i][1][2] * inv, s[i][1][3] * inv);
            const bf16x8 pf = __builtin_bit_cast(bf16x8, pw);
            const size_t tok = (size_t)b * SEQL + (rs + i) * 64 + kstart + 8 * g;
#pragma unroll
            for (int dt = 0; dt < 4; ++dt) { const bf16x8 vf = *(const bf16x8*)(VT + (size_t)(h * 64 + dt * 16 + l16) * MP + tok); o[dt] = mfma16(vf, pf, o[dt]); }
        }
    }
    { u32x4 pw; pw.x = pk2(sm[0] * inv, sm[1] * inv); pw.y = pk2(sm[2] * inv, sm[3] * inv); pw.z = 0u; pw.w = 0u;
      const bf16x8 pf = __builtin_bit_cast(bf16x8, pw);
#pragma unroll
      for (int dt = 0; dt < 4; ++dt) { const u32x2 v2 = *(const u32x2*)(VT + (size_t)(h * 64 + dt * 16 + l16) * MP + mrow0 + 4 * g);
          u32x4 vw; vw.x = v2.x; vw.y = v2.y; vw.z = 0u; vw.w = 0u; o[dt] = mfma16(__builtin_bit_cast(bf16x8, vw), pf, o[dt]); } }
#pragma unroll
    for (int dt = 0; dt < 4; ++dt) { u32x2 w; w.x = pk2(o[dt][0], o[dt][1]); w.y = pk2(o[dt][2], o[dt][3]); *(u32x2*)(AO + qrow * 1024 + h * 64 + dt * 16 + 4 * g) = w; }
}
__device__ __forceinline__ void na_phase(const bf16_t* QK, const bf16_t* VT, const float* relb, const float* metab, bf16_t* AO) {
    const int tid = opaque_tid(), lane = tid & 63, wave = tid >> 6;
    for (int bu = blockIdx.x; bu < 4096 + 8; bu += gridDim.x) {
        if (bu < 4096) { const int u = bu * 8 + wave; const int j = u & 3, r = (u >> 2) & 127, h = (u >> 9) & 15, b = u >> 13;
            na_unit<false>(QK, VT, relb + h * 465, metab + h * 16, AO, b, h, r, j, lane); }
        else { const int mu = (bu - 4096) * 8 + wave; const int b = mu >> 4, h = mu & 15;
            na_unit<true>(QK, VT, relb + h * 465, metab + h * 16, AO, b, h, 0, 0, lane); }
    }
}

__device__ __forceinline__ void rope_phase(bf16_t* QKV, const float* qn, const float* kn, const f32x2* tab) {
    const int tid = opaque_tid(), lane = tid & 63, wave = tid >> 6, l16 = lane & 15, hq = lane >> 4;
    const int gw = blockIdx.x * NWAVES + wave, NGW = gridDim.x * NWAVES;
    const float C2 = 0.125f * 1.4426950408889634f;
    for (int row = gw; row < MR + NMROWS; row += NGW) {
        int pr = 0, pc = 0; if (row < MR) { const int t = row & (SEQL - 1); pr = t >> 6; pc = t & 63; }
        const f32x2 cr = tab[pr * 16 + l16], cc = tab[pc * 16 + l16];
#pragma unroll
        for (int pass = 0; pass < 5; ++pass) {
            const int hh = pass * 4 + hq; bf16_t* p = QKV + (size_t)row * 1536 + hh * 64 + l16;
            float x0 = bf2f(p[0]), x1 = bf2f(p[16]), x2 = bf2f(p[32]), x3 = bf2f(p[48]);
            float ssq = (x0 * x0 + x1 * x1) + (x2 * x2 + x3 * x3);
            ssq += __shfl_xor(ssq, 1); ssq += __shfl_xor(ssq, 2); ssq += __shfl_xor(ssq, 4); ssq += __shfl_xor(ssq, 8);
            const float rs = rsqrtf(ssq * (1.0f / 64.0f) + RMS_EPS);
            const float* gn = (hh < 16) ? qn : kn;
            x0 *= rs * gn[l16]; x1 *= rs * gn[16 + l16]; x2 *= rs * gn[32 + l16]; x3 *= rs * gn[48 + l16];
            float o0 = x0 * cr.x - x1 * cr.y, o1 = x1 * cr.x + x0 * cr.y, o2 = x2 * cc.x - x3 * cc.y, o3 = x3 * cc.x + x2 * cc.y;
            if (hh < 16) { o0 *= C2; o1 *= C2; o2 *= C2; o3 *= C2; }
            p[0] = (bf16_t)(pk2(o0, 0.f) & 0xffffu); p[16] = (bf16_t)(pk2(o1, 0.f) & 0xffffu); p[32] = (bf16_t)(pk2(o2, 0.f) & 0xffffu); p[48] = (bf16_t)(pk2(o3, 0.f) & 0xffffu);
        }
    }
}
constexpr int ML_SQ = 0, ML_SK = 17408, ML_SKT = 34816, ML_SVT = 53248, ML_SS = 57856, ML_SC = 67072, ML_F = 75776;
constexpr int QP = 136, TP = 72;
__device__ __forceinline__ long ml_row(int b, int dir, int ci, int s) {
    if (dir == 0) { if (ci == 0) return (s < 16) ? (long)MR + b * 16 + s : -1; return (long)b * SEQL + (ci - 1) * 64 + s; }
    if (ci < 128) return (long)b * SEQL + (127 - ci) * 64 + (63 - s);
    return (s < 16) ? (long)MR + b * 16 + 15 - s : -1;
}
__device__ __forceinline__ void mlstm_item(LAS unsigned char* lds, const bf16_t* __restrict__ P, const float* __restrict__ gates, const float* __restrict__ gbias, bf16_t* __restrict__ Hout, int b, int head, int dir, int sl) {
    const int tid = opaque_tid(), lane = tid & 63, wave = tid >> 6, l16 = lane & 15, g = lane >> 4;
    LAS bf16_t* sQ = (LAS bf16_t*)(lds + ML_SQ); LAS bf16_t* sK = (LAS bf16_t*)(lds + ML_SK); LAS bf16_t* sKt = (LAS bf16_t*)(lds + ML_SKT);
    LAS bf16_t* sVt = (LAS bf16_t*)(lds + ML_SVT); LAS bf16_t* sS = (LAS bf16_t*)(lds + ML_SS); LAS bf16_t* sC = (LAS bf16_t*)(lds + ML_SC);
    LAS float* sBc = (LAS float*)(lds + ML_F); LAS float* sA = sBc + 64; LAS float* sMt = sA + 64; LAS float* sWi = sMt + 64; LAS float* sWk = sWi + 64; LAS float* sEi = sWk + 64;
    LAS float* sDenP = sEi + 64; LAS float* sQN = sDenP + 128; LAS float* sN = sQN + 512; LAS float* sScal = sN + 128; LAS int* sRow = (LAS int*)(sScal + 4);
    const float kscale = 0.08838834764831845f;
    const float bias_i = gbias[(2 * dir) * 4 + head], bias_f = gbias[(2 * dir + 1) * 4 + head];
    for (int i = tid; i < 32 * QP; i += NTHR) sC[i] = 0;
    if (tid < 128) sN[tid] = 0.f;
    f32x4 accC[2]; accC[0] = (f32x4){0.f, 0.f, 0.f, 0.f}; accC[1] = accC[0];
    float m_prev = 0.f;
    const int ss_ = tid >> 3, d0 = (tid & 7) * 16;
    const int vs_ = tid >> 2, v0 = (tid & 3) * 8;
    u32x4 rq0, rq1, rk0, rk1, rv; float rgi = 0.f, rgf = 0.f; long rrow = -1;
#define ML_LOAD(ci) do { \
        const long row_ = ml_row(b, dir, (ci), ss_); \
        rq0 = rq1 = rk0 = rk1 = (u32x4){0u, 0u, 0u, 0u}; \
        if (row_ >= 0) { const bf16_t* pr_ = P + row_ * 3072 + head * 128 + d0; rq0 = *(const u32x4*)pr_; rq1 = *(const u32x4*)(pr_ + 8); rk0 = *(const u32x4*)(pr_ + 512); rk1 = *(const u32x4*)(pr_ + 520); } \
        rv = (u32x4){0u, 0u, 0u, 0u}; \
        if (tid < 256) { const long rowv_ = ml_row(b, dir, (ci), vs_); if (rowv_ >= 0) rv = *(const u32x4*)(P + rowv_ * 3072 + 1024 + head * 256 + sl * 32 + v0); } \
        if (tid < 64) { rrow = ml_row(b, dir, (ci), tid); rgi = 0.f; rgf = 0.f; if (rrow >= 0) { rgi = gates[rrow * 16 + (2 * dir) * 4 + head]; rgf = gates[rrow * 16 + (2 * dir + 1) * 4 + head]; } } \
    } while (0)
    ML_LOAD(0);
    __syncthreads();
    for (int ci = 0; ci < 129; ++ci) {
        *(LAS u32x4*)(sQ + ss_ * QP + d0) = rq0; *(LAS u32x4*)(sQ + ss_ * QP + d0 + 8) = rq1;
        *(LAS u32x4*)(sK + ss_ * QP + d0) = rk0; *(LAS u32x4*)(sK + ss_ * QP + d0 + 8) = rk1;
        { const unsigned kw[8] = {rk0.x, rk0.y, rk0.z, rk0.w, rk1.x, rk1.y, rk1.z, rk1.w};
#pragma unroll
          for (int e = 0; e < 8; ++e) { sKt[(d0 + 2 * e) * TP + ss_] = (bf16_t)(kw[e] & 0xffffu); sKt[(d0 + 2 * e + 1) * TP + ss_] = (bf16_t)(kw[e] >> 16); } }
        if (tid < 256) { const unsigned vw[4] = {rv.x, rv.y, rv.z, rv.w};
#pragma unroll
          for (int e = 0; e < 4; ++e) { sVt[(v0 + 2 * e) * TP + vs_] = (bf16_t)(vw[e] & 0xffffu); sVt[(v0 + 2 * e + 1) * TP + vs_] = (bf16_t)(vw[e] >> 16); } }
        if (wave == 0) {
            const bool valid = rrow >= 0;
            const float xf = rgf + bias_f;
            const float li = valid ? rgi + bias_i : -INFINITY;
            const float lf = valid ? (fminf(xf, 0.f) - log1pf(__expf(-fabsf(xf)))) : 0.f;
            float bc = lf;
#pragma unroll
            for (int o = 1; o < 64; o <<= 1) { const float t = __shfl_up(bc, o); if (lane >= o) bc += t; }
            const float av = li - bc;
            float pm = av;
#pragma unroll
            for (int o = 1; o < 64; o <<= 1) { const float t = __shfl_up(pm, o); if (lane >= o) pm = fmaxf(pm, t); }
            const float inter = bc + m_prev, mt = fmaxf(inter, bc + pm);
            const float blast = __shfl(bc, 63), pml = __shfl(pm, 63);
            const float m_new = fmaxf(blast + m_prev, blast + pml);
            sBc[lane] = bc; sA[lane] = av; sMt[lane] = mt; sWi[lane] = __expf(inter - mt); sEi[lane] = __expf(-mt);
            sWk[lane] = __expf(blast + av - m_new) * kscale;
            sRow[lane] = (int)rrow;
            if (lane == 0) sScal[0] = __expf(blast + m_prev - m_new);
            m_prev = m_new;
        }
        __syncthreads();
        if (ci + 1 < 129) ML_LOAD(ci + 1);
        const int tt = wave >> 1;
        {
            float rsum[4] = {0.f, 0.f, 0.f, 0.f};
#pragma unroll
            for (int si = 0; si < 2; ++si) {
                const int st = 2 * (wave & 1) + si;
                f32x4 acc = (f32x4){0.f, 0.f, 0.f, 0.f};
                if (st <= tt) {
#pragma unroll
                    for (int ks = 0; ks < 4; ++ks) { const bf16x8 af = *(const LAS bf16x8*)(sQ + (tt * 16 + l16) * QP + 32 * ks + 8 * g); const bf16x8 bf = *(const LAS bf16x8*)(sK + (st * 16 + l16) * QP + 32 * ks + 8 * g); acc = mfma16(af, bf, acc); }
                }
                const int scol = st * 16 + l16; const float as = sA[scol];
#pragma unroll
                for (int e = 0; e < 4; ++e) { const int t = tt * 16 + 4 * g + e;
                    float w = 0.f; if (scol <= t) w = kscale * __expf(sBc[t] + as - sMt[t]);
                    const float v = acc[e] * w; rsum[e] += v; sS[t * TP + scol] = (bf16_t)(pk2(v, 0.f) & 0xffffu); }
            }
#pragma unroll
            for (int e = 0; e < 4; ++e) { float v = rsum[e]; v += __shfl_xor(v, 1); v += __shfl_xor(v, 2); v += __shfl_xor(v, 4); v += __shfl_xor(v, 8); if (l16 == 0) sDenP[(wave & 1) * 64 + tt * 16 + 4 * g + e] = v; }
        }
        { const int t = tid & 63, part = tid >> 6; float qn = 0.f;
#pragma unroll
          for (int d = 0; d < 16; ++d) qn += bf2f(sQ[t * QP + part * 16 + d]) * sN[part * 16 + d];
          sQN[part * 64 + t] = qn; }
        const int vt = wave & 1;
        f32x4 acch = (f32x4){0.f, 0.f, 0.f, 0.f};
#pragma unroll
        for (int ks = 0; ks < 4; ++ks) { const bf16x8 af = *(const LAS bf16x8*)(sQ + (tt * 16 + l16) * QP + 32 * ks + 8 * g); const bf16x8 bf = *(const LAS bf16x8*)(sC + (vt * 16 + l16) * QP + 32 * ks + 8 * g); acch = mfma16(af, bf, acch); }
#pragma unroll
        for (int e = 0; e < 4; ++e) acch[e] *= sWi[tt * 16 + 4 * g + e];
        __syncthreads();
#pragma unroll
        for (int ks = 0; ks < 2; ++ks) { const bf16x8 af = *(const LAS bf16x8*)(sS + (tt * 16 + l16) * TP + 32 * ks + 8 * g); const bf16x8 bf = *(const LAS bf16x8*)(sVt + (vt * 16 + l16) * TP + 32 * ks + 8 * g); acch = mfma16(af, bf, acch); }
#pragma unroll
        for (int e = 0; e < 4; ++e) { const int t = tt * 16 + 4 * g + e;
            float qn = 0.f;
#pragma unroll
            for (int p = 0; p < 8; ++p) qn += sQN[p * 64 + t];
            const float den = sDenP[t] + sDenP[64 + t] + sWi[t] * qn;
            const float hv = acch[e] / fmaxf(fabsf(den), sEi[t]);
            const int row = sRow[t];
            if (row >= 0) Hout[(size_t)row * 1024 + head * 256 + sl * 32 + vt * 16 + l16] = (bf16_t)(pk2(hv, 0.f) & 0xffffu); }
        {
            const float decay = sScal[0];
            bf16x8 af[2];
#pragma unroll
            for (int ks = 0; ks < 2; ++ks) { const u32x4 vw = *(const LAS u32x4*)(sVt + (vt * 16 + l16) * TP + 32 * ks + 8 * g); const LAS float* wk = sWk + 32 * ks + 8 * g;
                u32x4 o; o.x = pk2(bflo(vw.x) * wk[0], bfhi(vw.x) * wk[1]); o.y = pk2(bflo(vw.y) * wk[2], bfhi(vw.y) * wk[3]); o.z = pk2(bflo(vw.z) * wk[4], bfhi(vw.z) * wk[5]); o.w = pk2(bflo(vw.w) * wk[6], bfhi(vw.w) * wk[7]);
                af[ks] = __builtin_bit_cast(bf16x8, o); }
#pragma unroll
            for (int di = 0; di < 2; ++di) { const int dt = 2 * (wave >> 1) + di;
                accC[di] = accC[di] * decay;
#pragma unroll
                for (int ks = 0; ks < 2; ++ks) { const bf16x8 bf = *(const LAS bf16x8*)(sKt + (dt * 16 + l16) * TP + 32 * ks + 8 * g); accC[di] = mfma16(af[ks], bf, accC[di]); }
#pragma unroll
                for (int e = 0; e < 4; ++e) sC[(vt * 16 + 4 * g + e) * QP + dt * 16 + l16] = (bf16_t)(pk2(accC[di][e], 0.f) & 0xffffu); }
            if (tid < 128) { float nv = sN[tid] * decay;
#pragma unroll
                for (int c8 = 0; c8 < 8; ++c8) { const u32x4 kw = *(const LAS u32x4*)(sKt + tid * TP + 8 * c8); const LAS float* wk = sWk + 8 * c8;
                    nv += bflo(kw.x) * wk[0] + bfhi(kw.x) * wk[1] + bflo(kw.y) * wk[2] + bfhi(kw.y) * wk[3] + bflo(kw.z) * wk[4] + bfhi(kw.z) * wk[5] + bflo(kw.w) * wk[6] + bfhi(kw.w) * wk[7]; }
                sN[tid] = nv; }
        }
        __syncthreads();
    }
#undef ML_LOAD
}
__device__ __forceinline__ void mlstm_phase(LAS unsigned char* lds, const bf16_t* P, const float* gates, const float* gbias, bf16_t* HF, bf16_t* HBW) {
    for (int it = blockIdx.x; it < 256; it += gridDim.x) {
        const int sl = it & 7, ch = it >> 3; const int dir = ch & 1, head = (ch >> 1) & 3, b = ch >> 3;
        mlstm_item(lds, P, gates, gbias, dir ? HBW : HF, b, head, dir, sl);
        __syncthreads();
    }
}
__device__ __forceinline__ void mlstm_combine_phase(const bf16_t* P, const bf16_t* HF, bf16_t* AO, const float* onorm) {
    const int tid = opaque_tid(), lane = tid & 63, wave = tid >> 6;
    const int gw = blockIdx.x * NWAVES + wave, NGW = gridDim.x * NWAVES;
    for (int row = gw; row < MR + NMROWS; row += NGW) {
#pragma unroll
        for (int hd = 0; hd < 4; ++hd) {
            const int col = hd * 256 + 4 * lane;
            const u32x2 a = *(const u32x2*)(HF + (size_t)row * 1024 + col), c = *(const u32x2*)(AO + (size_t)row * 1024 + col), op = *(const u32x2*)(P + (size_t)row * 3072 + 2048 + col);
            float h0 = bflo(a.x) + bflo(c.x), h1 = bfhi(a.x) + bfhi(c.x), h2 = bflo(a.y) + bflo(c.y), h3 = bfhi(a.y) + bfhi(c.y);
            const float ssq = wave_sum((h0 * h0 + h1 * h1) + (h2 * h2 + h3 * h3));
            const float rs = rsqrtf(ssq * (1.0f / 256.0f) + RMS_EPS);
            const f32x4 gn = *(const f32x4*)(onorm + col);
            const float o0 = bflo(op.x), o1 = bfhi(op.x), o2 = bflo(op.y), o3 = bfhi(op.y);
            h0 = h0 * rs * gn[0] / (1.f + __expf(-o0)); h1 = h1 * rs * gn[1] / (1.f + __expf(-o1)); h2 = h2 * rs * gn[2] / (1.f + __expf(-o2)); h3 = h3 * rs * gn[3] / (1.f + __expf(-o3));
            u32x2 w; w.x = pk2(h0, h1); w.y = pk2(h2, h3); *(u32x2*)(AO + (size_t)row * 1024 + col) = w;
        }
    }
}
__device__ __forceinline__ void final_phase(float* out, const float* ss, const float* gfin) {
    const int tid = opaque_tid(), lane = tid & 63, wave = tid >> 6;
    const int gw = blockIdx.x * NWAVES + wave, NGW = gridDim.x * NWAVES;
    for (int row = gw; row < MR; row += NGW) {
        const float rs = rstd_of(ss + (size_t)row * 16);
#pragma unroll
        for (int j = 0; j < 4; ++j) { f32x4* p = (f32x4*)(out + (size_t)row * 1024 + 256 * j + 4 * lane); const f32x4 gn = *(const f32x4*)(gfin + 256 * j + 4 * lane); f32x4 v = *p;
            v[0] *= rs * gn[0]; v[1] *= rs * gn[1]; v[2] *= rs * gn[2]; v[3] *= rs * gn[3]; *p = v; }
    }
}

constexpr int N_PHASES = 30;
#ifndef EN_PRO
#define EN_PRO 1
#endif
#ifndef EN_GEMM0
#define EN_GEMM0 1
#endif
#ifndef EN_GEMM1
#define EN_GEMM1 1
#endif
#ifndef EN_GEMM2
#define EN_GEMM2 1
#endif
#ifndef EN_NA
#define EN_NA 1
#endif
#ifndef EN_ATTN
#define EN_ATTN 1
#endif
#ifndef EN_ML
#define EN_ML 1
#endif
__device__ __forceinline__ bool phase_active(int ph) {
    if (ph == 0 || ph == 29) return true;
    const int layer = (ph - 1) / 7, s = (ph - 1) % 7;
    if (s == 1) return layer == 1;
    if (s == 3) return layer == 2;
    return true;
}
__global__ void __launch_bounds__(NTHR, 2) fwd_kernel(Args args) {
    extern __shared__ __attribute__((aligned(16))) unsigned char lds_raw[];
    LAS unsigned char* lds = (LAS unsigned char*)lds_raw;
    cg::grid_group grid = cg::this_grid();
    unsigned char* ws = args.ws;
    bf16_t* HB = (bf16_t*)(ws + OFF_HB); bf16_t* AO = (bf16_t*)(ws + OFF_AO); bf16_t* QKV = (bf16_t*)(ws + OFF_QKV); bf16_t* VT = (bf16_t*)(ws + OFF_VT);
    float* HX = (float*)(ws + OFF_HX); float* SS = (float*)(ws + OFF_SS); float* GATES = (float*)(ws + OFF_GATES);
    bool did = false;
    for (int ph = args.ph_lo; ph < args.ph_hi; ++ph) {
        if (!phase_active(ph)) continue;
        if (did) grid.sync();
        did = true;
        if (ph == 0) { if (EN_PRO) prologue_phase(args, lds); continue; }
        if (ph == 29) { final_phase(args.out, SS + (size_t)8 * MP * 16, args.in[4]); continue; }
        const int layer = (ph - 1) / 7, s = (ph - 1) % 7;
        const int kind = (layer == 1) ? 1 : (layer == 2) ? 2 : 0, ja = (layer == 3) ? 1 : 0;
        const float* ss_mix = SS + (size_t)(2 * layer) * MP * 16; float* ss_ffn = SS + (size_t)(2 * layer + 1) * MP * 16; float* ss_next = SS + (size_t)(2 * layer + 2) * MP * 16;
        if (s == 0) { if (EN_GEMM0) {
            const bf16_t* W = (kind == 0) ? (const bf16_t*)(ws + OFF_W_AQKV + (size_t)ja * 6 * MiB) : (kind == 1) ? (const bf16_t*)(ws + OFF_W_BQKV) : (const bf16_t*)(ws + OFF_W_CIN);
            const int N = (kind == 0) ? 2048 : (kind == 1) ? 1536 : 3328;
            const int ldc = (kind == 0) ? 2048 : (kind == 1) ? 1536 : 3072;
            pg8::Gemm gm{HB, W, MP, N, 1024}; pg8::StaticOrder S; S.init(MP, N, gridDim.x, blockIdx.x);
            EpiScaleBf16 E{QKV, ldc, ss_mix, GATES, (kind == 2) ? 12 : -1};
            pg8::gemm_phase<EpiScaleBf16, pg8::StaticOrder, true, true>(lds, gm, S, E);
            if (kind == 0) {
                pg8::Gemm g2{W + (size_t)2048 * 1024, HB, 1024, MP, 1024}; pg8::StaticOrder S2; S2.init(1024, MP, gridDim.x, blockIdx.x);
                EpiScaleColBf16 E2{VT, MP, ss_mix};
                pg8::gemm_phase<EpiScaleColBf16, pg8::StaticOrder, true, true>(lds, g2, S2, E2);
            } }
        } else if (s == 1) {
            rope_phase(QKV, args.in[10], args.in[11], (const f32x2*)(ws + OFF_ROPE));
        } else if (s == 2) {
            if (kind == 0) { if (EN_NA) na_phase(QKV, VT, args.in[6] + (size_t)ja * 16 * 465, args.in[7] + (size_t)ja * 256, AO); }
            else if (kind == 1) { if (EN_ATTN) {
                const int xcd = blockIdx.x & 7, l = blockIdx.x >> 3;
                if (gridDim.x == 256) {
                    for (int i = 0; i < 8; ++i) { const int pair = 2 * xcd + (i >> 2); const int b = pair >> 2, kvh = pair & 3;
                        attn_body::attn_unit<8>(b, kvh * 4 + (i & 3), l, (const attn_body::bf16*)QKV, (attn_body::bf16*)AO, (char*)lds_raw); }
                    if (blockIdx.x < 16) attn_body::attn_unit<8>(blockIdx.x >> 2, (blockIdx.x & 3) * 4, 32, (const attn_body::bf16*)QKV, (attn_body::bf16*)AO, (char*)lds_raw);
                } else {
                    for (int u = blockIdx.x; u < 2048 + 16; u += gridDim.x) {
                        if (u < 2048) attn_body::attn_unit<8>(u >> 9, (u >> 5) & 15, u & 31, (const attn_body::bf16*)QKV, (attn_body::bf16*)AO, (char*)lds_raw);
                        else attn_body::attn_unit<8>((u - 2048) >> 2, ((u - 2048) & 3) * 4, 32, (const attn_body::bf16*)QKV, (attn_body::bf16*)AO, (char*)lds_raw); }
                } }
            } else { if (EN_ML) mlstm_phase(lds, QKV, GATES, args.in[14], HB, AO); }
        } else if (s == 3) {
            mlstm_combine_phase(QKV, HB, AO, args.in[15]);
        } else if (s == 4 || s == 6) { if (EN_GEMM1) {
            const bf16_t* W = (s == 6) ? (const bf16_t*)(ws + OFF_W2 + (size_t)layer * 11 * MiB / 2)
                            : (kind == 0) ? (const bf16_t*)(ws + OFF_W_AO + (size_t)ja * 2 * MiB) : (kind == 1) ? (const bf16_t*)(ws + OFF_W_BO) : (const bf16_t*)(ws + OFF_W_CO);
            pg8::Gemm gm{(s == 6) ? QKV : AO, W, MP, 1024, (s == 6) ? FFH : 1024}; pg8::StaticOrder S; S.init(MP, 1024, gridDim.x, blockIdx.x);
            EpiResid E{args.out, HX, HB, (s == 6) ? ss_next : ss_ffn};
            pg8::gemm_phase<EpiResid, pg8::StaticOrder, true, true>(lds, gm, S, E); }
        } else if (EN_GEMM2) {
            pg8::Gemm gm{HB, (const bf16_t*)(ws + OFF_W13 + (size_t)layer * 11 * MiB), MP, 2 * FFH, 1024}; pg8::StaticOrder S; S.init(MP, 2 * FFH, gridDim.x, blockIdx.x);
            EpiSwiglu E{QKV, ss_ffn};
            pg8::gemm_phase<EpiSwiglu, pg8::StaticOrder, true, true>(lds, gm, S, E);
        }
    }
}

#ifndef ONE_LAUNCH
#define ONE_LAUNCH 1
#endif
extern "C" void kernel_launch(void* const* d_in, const int* in_sizes, int n_in, void* d_out, int out_size, void* d_ws, size_t ws_size, hipStream_t stream) {
    static int grid = 0;
    if (grid == 0) {
        if (n_in != 20 || out_size != MR * 1024 || ws_size < WS_END) { fprintf(stderr, "kernel_launch: unexpected shapes (n_in %d out %d ws %zu)\n", n_in, out_size, ws_size); grid = -1; return; }
        int dev = 0, cus = 0, per_cu = 0;
        hipGetDevice(&dev); hipDeviceGetAttribute(&cus, hipDeviceAttributeMultiprocessorCount, dev);
        if (hipFuncSetAttribute((const void*)fwd_kernel, hipFuncAttributeMaxDynamicSharedMemorySize, LDS_BYTES) != hipSuccess) { fprintf(stderr, "kernel_launch: hipFuncSetAttribute failed\n"); grid = -1; return; }
        if (hipOccupancyMaxActiveBlocksPerMultiprocessor(&per_cu, (const void*)fwd_kernel, NTHR, LDS_BYTES) != hipSuccess || per_cu < 1) { fprintf(stderr, "kernel_launch: occupancy query says %d\n", per_cu); per_cu = 1; }
        (void)hipGetLastError();
        grid = cus;
    }
    if (grid < 0) return;
    Args a{};
    for (int i = 0; i < 20; ++i) a.in[i] = (const float*)d_in[i];
    a.out = (float*)d_out; a.ws = (unsigned char*)d_ws;
#if ONE_LAUNCH
    a.ph_lo = 0; a.ph_hi = N_PHASES;
    void* kargs[] = {&a};
    hipError_t e = hipLaunchCooperativeKernel((const void*)fwd_kernel, dim3(grid), dim3(NTHR), kargs, LDS_BYTES, stream);
    if (e != hipSuccess) fprintf(stderr, "kernel_launch: cooperative launch failed: %s (grid %d)\n", hipGetErrorString(e), grid);
#else
    for (int ph = 0; ph < N_PHASES; ++ph) {
        a.ph_lo = ph; a.ph_hi = ph + 1;
        hipLaunchKernelGGL(fwd_kernel, dim3(grid), dim3(NTHR), LDS_BYTES, stream, a);
    }
#endif
}
```

```cpp
#include <hip/hip_runtime.h>
#include <hip/hip_cooperative_groups.h>
#include <hip/hip_bf16.h>
#include <cstdio>
#include <cstdint>
#include <cmath>
namespace cg = cooperative_groups;
namespace pg8 {
#define PG8_LAS __attribute__((address_space(3)))
typedef unsigned short bf16_t;
typedef short bf16x8 __attribute__((ext_vector_type(8)));
typedef float f32x4 __attribute__((ext_vector_type(4)));
typedef unsigned u32x4 __attribute__((ext_vector_type(4)));
constexpr int BM = 256, BK = 64, HALF = 128, HTB = HALF * BK * 2  , STAGE_BYTES = 8 * HTB, NXCD = 8, WGM = 4;

__host__ __device__ __forceinline__ int lds_byte(int r, int c) { const int st = (r >> 4) * 2 + (c >> 5), rr = r & 15, cc = c & 31, ob = rr * 64 + cc * 2; return st * 1024 + (ob ^ (((ob >> 9) & 1) << 5)); }
__host__ __device__ __forceinline__ void stage_rc(int b, int& R, int& C) { const int st = b / 1024, sb = b % 1024, swz = sb ^ (((sb >> 9) & 1) << 5); R = (st >> 1) * 16 + swz / 64; C = (st & 1) * 32 + (swz % 64) / 2; }
__host__ __device__ __forceinline__ int perm32(int rho) { const int n = rho >> 4, i = rho & 15; return 8 * (i >> 2) + 4 * n + (i & 3); }

struct Unit { int pm, pn; };
struct Gemm { const bf16_t* A; const bf16_t* Bt; int M, N, K; };

struct StaticOrder {
    int nM, nN, nwg, G, c;
    __host__ __device__ void init(int M, int N, int G_, int c_) { nM = M / BM; nN = N / BM; nwg = nM * nN; G = G_; c = c_; }
    __host__ __device__ bool next(int i, Unit& u) const {
        const long L = (long)i * G + c; if (L >= nwg) return false;
        int wgid = (int)L; { const int q = nwg / NXCD, r = nwg % NXCD, xcd = wgid % NXCD, off = wgid / NXCD; wgid = (xcd < r ? xcd * (q + 1) : r * (q + 1) + (xcd - r) * q) + off; }
        const int nig = WGM * nN, gid = wgid / nig, fm = gid * WGM, gsz = (nM - fm) < WGM ? (nM - fm) : WGM;
        u.pm = fm + ((wgid % nig) % gsz); u.pn = (wgid % nig) / gsz; return true;
    }
    __device__ __forceinline__ void a_ready(const Unit&) const {}
    __device__ __forceinline__ void done(const Unit&) const {}
};

__device__ __forceinline__ unsigned cvt_pk_bf16(float lo, float hi) { unsigned r; asm volatile("v_cvt_pk_bf16_f32 %0, %1, %2" : "=v"(r) : "v"(lo), "v"(hi)); return r; }
template <class Epi, class Sched, bool ALIGN_EPI = false, bool SP2 = false>
__device__ __forceinline__ void gemm_phase(PG8_LAS unsigned char* lds, const Gemm g, const Sched& S, const Epi& E) {
    int tid_ = threadIdx.x; asm volatile("" : "+v"(tid_));
    const int tid = tid_, wid = __builtin_amdgcn_readfirstlane(tid >> 6), lane = tid & 63, wr = wid >> 2, wc = wid & 3, fr = lane & 15, fq = lane >> 4;
    const int K = g.K, nt = K / BK;
    unsigned voffA[2], voffB[2];
#pragma unroll
    for (int i = 0; i < 2; ++i) { int R, C; stage_rc(tid * 16 + i * 8192, R, C); const int Rb = Epi::PERM ? ((R & ~31) + perm32(R & 31)) : R;
        voffA[i] = (unsigned)(R * K + C) * 2u; voffB[i] = (unsigned)(Rb * K + C) * 2u; }
    const size_t kstep = (size_t)(BK * 2);
    const size_t hstep = (size_t)HALF * K * 2;
    const size_t tstep = 2 * hstep;
    const unsigned ldsw = (unsigned)wid * 1024u;
    const int aoff = lds_byte(wr * 64 + fr, fq * 8), boff = lds_byte(wc * 32 + fr, fq * 8);
#define PG8_SA(b, h) (((b) * 2 + (h)) * HTB)
#define PG8_SB(b, h) ((4 + (b) * 2 + (h)) * HTB)
#define PG8_STAGE(bufoff, gbase, voff) do { _Pragma("unroll") for (int _i = 0; _i < 2; ++_i) \
        __builtin_amdgcn_global_load_lds((const unsigned*)((const char*)(gbase) + (voff)[_i]), (PG8_LAS unsigned*)(lds + (bufoff) + ldsw + _i * 8192), 16, 0, 0); } while (0)
#define PG8_LDA(dst, b, h) do { _Pragma("unroll") for (int m = 0; m < 4; ++m) _Pragma("unroll") for (int k = 0; k < 2; ++k) dst[m][k] = *(const PG8_LAS bf16x8*)(lds + PG8_SA(b, h) + aoff + m * 2048 + k * 1024); } while (0)
#define PG8_LDB(dst, b, h) do { _Pragma("unroll") for (int n = 0; n < 2; ++n) _Pragma("unroll") for (int k = 0; k < 2; ++k) dst[n][k] = *(const PG8_LAS bf16x8*)(lds + PG8_SB(b, h) + boff + n * 2048 + k * 1024); } while (0)
#define PG8_MMA(ai, bj, At, Bt) do { __builtin_amdgcn_s_setprio(1); _Pragma("unroll") for (int m = 0; m < 4; ++m) _Pragma("unroll") for (int n = 0; n < 2; ++n) _Pragma("unroll") for (int k = 0; k < 2; ++k) \
        acc[ai][bj][m][n] = __builtin_amdgcn_mfma_f32_16x16x32_bf16(Bt[n][k], At[m][k], acc[ai][bj][m][n], 0, 0, 0); __builtin_amdgcn_s_setprio(0); } while (0)
#define PG8_WAIT_V(n) asm volatile("s_waitcnt vmcnt(" #n ")" ::: "memory")
#define PG8_WAIT_L(n) asm volatile("s_waitcnt lgkmcnt(" #n ")" ::: "memory")
#define PG8_BAR __builtin_amdgcn_s_barrier()
#define PG8_SCHED __builtin_amdgcn_sched_barrier(0)
    Unit cur, nxt; int ui = 0;
    if (!S.next(0, cur)) return;
    f32x4 acc[2][2][4][2];
#pragma unroll
    for (int a = 0; a < 2; ++a)
#pragma unroll
        for (int b = 0; b < 2; ++b)
#pragma unroll
            for (int m = 0; m < 4; ++m)
#pragma unroll
                for (int n = 0; n < 2; ++n) acc[a][b][m][n] = (f32x4){0.f, 0.f, 0.f, 0.f};
    bf16x8 At[4][2], B0[2][2], B1[2][2];
    const char* cA = (const char*)g.A + (size_t)cur.pm * tstep; const char* cB = (const char*)g.Bt + (size_t)cur.pn * tstep;
    S.a_ready(cur);
    if constexpr (SP2) {
        PG8_STAGE(PG8_SB(0, 0), cB, voffB); PG8_STAGE(PG8_SB(0, 1), cB + hstep, voffB); PG8_STAGE(PG8_SA(0, 0), cA, voffA); PG8_STAGE(PG8_SA(0, 1), cA + hstep, voffA);
        if (wr == 1) PG8_BAR;
        PG8_WAIT_V(2); PG8_BAR;
        PG8_STAGE(PG8_SB(1, 0), cB + kstep, voffB); PG8_STAGE(PG8_SA(1, 0), cA + kstep, voffA); PG8_STAGE(PG8_SB(1, 1), cB + hstep + kstep, voffB);
        PG8_WAIT_V(6); PG8_BAR;
    } else {
        PG8_STAGE(PG8_SB(0, 0), cB, voffB); PG8_STAGE(PG8_SA(0, 0), cA, voffA); PG8_STAGE(PG8_SB(0, 1), cB + hstep, voffB); PG8_STAGE(PG8_SA(0, 1), cA + hstep, voffA);
        if (wr == 1) PG8_BAR;
        PG8_WAIT_V(4); PG8_BAR;
        PG8_STAGE(PG8_SB(1, 0), cB + kstep, voffB); PG8_STAGE(PG8_SA(1, 0), cA + kstep, voffA); PG8_STAGE(PG8_SB(1, 1), cB + hstep + kstep, voffB);
        PG8_WAIT_V(6); PG8_BAR;
    }
    for (;;) {
        const bool has_next = S.next(ui + 1, nxt);
        const char* nA = has_next ? (const char*)g.A + (size_t)nxt.pm * tstep : cA; const char* nB = has_next ? (const char*)g.Bt + (size_t)nxt.pn * tstep : cB;
        for (int t = 0; t < nt; t += 2) {
            const bool last = (t == nt - 2);
            const char* a1 = cA + (size_t)(t + 1) * kstep;
            const char* a2 = last ? nA : cA + (size_t)(t + 2) * kstep; const char* b2 = last ? nB : cB + (size_t)(t + 2) * kstep;
            const char* a3 = a2 + kstep; const char* b3 = b2 + kstep;
            if (last && has_next) S.a_ready(nxt);
            if constexpr (SP2) {
            PG8_LDB(B0, 0, 0); PG8_LDB(B1, 0, 1); PG8_SCHED; PG8_LDA(At, 0, 0); PG8_STAGE(PG8_SA(1, 1), a1 + hstep, voffA);
            PG8_WAIT_V(8); PG8_WAIT_L(0); PG8_BAR; PG8_MMA(0, 0, At, B0); PG8_MMA(0, 1, At, B1); PG8_BAR; PG8_SCHED;
            PG8_LDA(At, 0, 1); PG8_STAGE(PG8_SB(0, 0), b2, voffB); PG8_STAGE(PG8_SB(0, 1), b2 + hstep, voffB); PG8_STAGE(PG8_SA(0, 0), a2, voffA);
            PG8_WAIT_V(8); PG8_WAIT_L(0); PG8_BAR; PG8_MMA(1, 0, At, B0); PG8_MMA(1, 1, At, B1); PG8_BAR; PG8_SCHED;
            PG8_LDB(B0, 1, 0); PG8_LDB(B1, 1, 1); PG8_SCHED; PG8_LDA(At, 1, 0); PG8_STAGE(PG8_SA(0, 1), a2 + hstep, voffA);
            PG8_WAIT_V(8); PG8_WAIT_L(0); PG8_BAR; PG8_MMA(0, 0, At, B0); PG8_MMA(0, 1, At, B1); PG8_BAR; PG8_SCHED;
            PG8_LDA(At, 1, 1); PG8_STAGE(PG8_SB(1, 0), b3, voffB); PG8_STAGE(PG8_SB(1, 1), b3 + hstep, voffB); PG8_STAGE(PG8_SA(1, 0), a3, voffA);
            PG8_WAIT_V(8); PG8_WAIT_L(0); PG8_BAR; PG8_MMA(1, 0, At, B0); PG8_MMA(1, 1, At, B1); PG8_BAR; PG8_SCHED;
            } else {
            PG8_LDB(B0, 0, 0); PG8_SCHED; PG8_LDA(At, 0, 0); PG8_STAGE(PG8_SA(1, 1), a1 + hstep, voffA);
            PG8_WAIT_L(8); PG8_BAR; PG8_WAIT_L(0); PG8_MMA(0, 0, At, B0); PG8_BAR; PG8_SCHED;
            PG8_LDB(B1, 0, 1); PG8_STAGE(PG8_SB(0, 0), b2, voffB);
            PG8_BAR; PG8_WAIT_L(0); PG8_MMA(0, 1, At, B1); PG8_BAR;
            PG8_LDA(At, 0, 1); PG8_STAGE(PG8_SA(0, 0), a2, voffA);
            PG8_BAR; PG8_WAIT_L(0); PG8_MMA(1, 0, At, B0); PG8_BAR; PG8_SCHED;
            PG8_STAGE(PG8_SB(0, 1), b2 + hstep, voffB);
            PG8_WAIT_V(6); PG8_BAR; PG8_MMA(1, 1, At, B1); PG8_BAR;
            PG8_LDB(B0, 1, 0); PG8_SCHED; PG8_LDA(At, 1, 0); PG8_STAGE(PG8_SA(0, 1), a2 + hstep, voffA);
            PG8_WAIT_L(8); PG8_BAR; PG8_WAIT_L(0); PG8_MMA(0, 0, At, B0); PG8_BAR; PG8_SCHED;
            PG8_LDB(B1, 1, 1); PG8_STAGE(PG8_SB(1, 0), b3, voffB);
            PG8_BAR; PG8_WAIT_L(0); PG8_MMA(0, 1, At, B1); PG8_BAR;
            PG8_LDA(At, 1, 1); PG8_STAGE(PG8_SA(1, 0), a3, voffA);
            PG8_BAR; PG8_WAIT_L(0); PG8_MMA(1, 0, At, B0); PG8_BAR; PG8_SCHED;
            PG8_STAGE(PG8_SB(1, 1), b3 + hstep, voffB);
            PG8_WAIT_V(6); PG8_BAR; PG8_MMA(1, 1, At, B1); PG8_BAR;
            }
        }
        if constexpr (ALIGN_EPI) { if (wr == 0) PG8_BAR; }
        if constexpr (!Epi::AFTER_DRAIN) { E(acc, cur, wr, wc, fr, fq); S.done(cur); }
        if (!has_next) break;
#pragma unroll
        for (int a = 0; a < 2; ++a)
#pragma unroll
            for (int b = 0; b < 2; ++b)
#pragma unroll
                for (int m = 0; m < 4; ++m)
#pragma unroll
                    for (int n = 0; n < 2; ++n) acc[a][b][m][n] = (f32x4){0.f, 0.f, 0.f, 0.f};
        cur = nxt; cA = nA; cB = nB; ++ui;
        if constexpr (ALIGN_EPI) { if (wr == 1) PG8_BAR; }
    }
    PG8_WAIT_V(0);
    if constexpr (!ALIGN_EPI) { if (wr == 0) PG8_BAR; }
    PG8_BAR;
    if constexpr (Epi::AFTER_DRAIN) { E.fused(acc, cur, wr, wc, fr, fq, lds, wid, lane); S.done(cur); }
#undef PG8_SA
#undef PG8_SB
#undef PG8_STAGE
#undef PG8_LDA
#undef PG8_LDB
#undef PG8_MMA
#undef PG8_WAIT_V
#undef PG8_WAIT_L
#undef PG8_BAR
#undef PG8_SCHED
}
}
namespace attn_body {
using bf16=__hip_bfloat16;
using bf16x8=__attribute__((ext_vector_type(8)))short;
using s16x4=__attribute__((ext_vector_type(4)))short;
using f32x16=__attribute__((ext_vector_type(16)))float;
using u32x4=__attribute__((ext_vector_type(4)))unsigned;
constexpr int D=64,PQ=1536,PO=1024,SEQR=8192,MROW0=32768;
constexpr int NW=8,QBLK=32,QB=QBLK*NW,KVBLK=64;
__device__ __forceinline__ int crow(int r,int hi){return (r&3)+8*(r>>2)+4*hi;}
#define SBAR() __builtin_amdgcn_sched_barrier(0)
__device__ __forceinline__ void cmask(f32x16&p0,f32x16&p1,int jb,int hi){
  const float NEG=-INFINITY;
  #pragma unroll
  for(int r=0;r<16;++r){int kv=crow(r,hi); if(jb==1||kv>=16)p0[r]=NEG; p1[r]=NEG;}
}

constexpr int NSLOT=3, SLOTB=8192;
constexpr int LDS_K=0, LDS_V=NSLOT*SLOTB, LDS_WS=2*NSLOT*SLOTB, LDS_OST=LDS_WS+NW*64*4, LDS_BYTES=LDS_OST+NW*4096;
constexpr float C2=0.125f*1.4426950408889634f;
__device__ __forceinline__ void glds16(const void*gsrc,unsigned lds_dst){unsigned keep;
  asm volatile("s_mov_b32 %0, m0\n\ts_mov_b32 m0, %2\n\ts_nop 0\n\tglobal_load_lds_dwordx4 %1, off\n\ts_mov_b32 m0, %0":"=&s"(keep):"v"(gsrc),"s"(lds_dst):"memory");}
__device__ __forceinline__ float max3f(float a,float b,float c){float r;asm("v_max3_f32 %0, %1, %2, %3":"=v"(r):"v"(a),"v"(b),"v"(c));return r;}
__device__ __forceinline__ float max2f(float a,float b){float r;asm("v_max_f32_e32 %0, %1, %2":"=v"(r):"v"(a),"v"(b));return r;}
__device__ __forceinline__ float fadd_s(float a,float b){float r;asm("v_add_f32_e32 %0, %1, %2":"=v"(r):"v"(a),"v"(b));return r;}
__device__ __forceinline__ float fsub_s(float a,float b){float r;asm("v_sub_f32_e32 %0, %1, %2":"=v"(r):"v"(a),"v"(b));return r;}
typedef float f32x2_t __attribute__((ext_vector_type(2))); typedef __bf16 bf16x2_t __attribute__((ext_vector_type(2)));
__device__ __forceinline__ unsigned cvtpk_s(float lo,float hi){f32x2_t v={lo,hi};bf16x2_t b=__builtin_convertvector(v,bf16x2_t);return __builtin_bit_cast(unsigned,b);}
#define WAIT_BAR(N) asm volatile("s_waitcnt vmcnt(" #N ") lgkmcnt(0)\n\ts_barrier":::"memory")

__device__ __forceinline__ void qkt(f32x16&p0,f32x16&p1,const char*Kslot,const bf16x8*qr,const f32x16&negm,int r32,int hi){
  const char*kb=Kslot+hi*1024+r32*16;
  #pragma unroll
  for(int d0=0;d0<4;++d0){
    const bf16x8 b0=*reinterpret_cast<const bf16x8*>(kb+d0*2048);
    const bf16x8 b1=*reinterpret_cast<const bf16x8*>(kb+d0*2048+512);
    if(d0==0){p0=__builtin_amdgcn_mfma_f32_32x32x16_bf16(b0,qr[0],negm,0,0,0);p1=__builtin_amdgcn_mfma_f32_32x32x16_bf16(b1,qr[0],negm,0,0,0);}
    else{p0=__builtin_amdgcn_mfma_f32_32x32x16_bf16(b0,qr[d0],p0,0,0,0);p1=__builtin_amdgcn_mfma_f32_32x32x16_bf16(b1,qr[d0],p1,0,0,0);}}
}
typedef __attribute__((address_space(3))) const char* lds_cptr;
typedef short v4i16_t __attribute__((ext_vector_type(4)));
__device__ __forceinline__ void kload8(bf16x8*kf,lds_cptr kp){
  kf[0]=*(const __attribute__((address_space(3))) bf16x8*)(kp);      kf[1]=*(const __attribute__((address_space(3))) bf16x8*)(kp+512);
  kf[2]=*(const __attribute__((address_space(3))) bf16x8*)(kp+2048); kf[3]=*(const __attribute__((address_space(3))) bf16x8*)(kp+2560);
  kf[4]=*(const __attribute__((address_space(3))) bf16x8*)(kp+4096); kf[5]=*(const __attribute__((address_space(3))) bf16x8*)(kp+4608);
  kf[6]=*(const __attribute__((address_space(3))) bf16x8*)(kp+6144); kf[7]=*(const __attribute__((address_space(3))) bf16x8*)(kp+6656);
}
__device__ __forceinline__ void kload2(bf16x8*kf,lds_cptr kp,int j){ kf[2*j]=*(const __attribute__((address_space(3))) bf16x8*)(kp+j*2048); kf[2*j+1]=*(const __attribute__((address_space(3))) bf16x8*)(kp+j*2048+512); }
__device__ __forceinline__ s16x4 vtr(lds_cptr p){ return __builtin_bit_cast(s16x4,__builtin_amdgcn_ds_read_tr16_b64_v4i16((__attribute__((address_space(3))) v4i16_t*)p)); }
__device__ __forceinline__ float rowmax(const f32x16&p0,const f32x16&p1){
  float a=max3f(p0[0],p0[1],p1[0]),b=max3f(p0[2],p0[3],p1[1]);a=max3f(a,p1[2],p1[3]);
  #pragma unroll
  for(int r=4;r<16;r+=4){a=max3f(a,p0[r],p0[r+1]);b=max3f(b,p0[r+2],p0[r+3]);a=max3f(a,p1[r],p1[r+1]);b=max3f(b,p1[r+2],p1[r+3]);}
  const float m=max2f(a,b);
  auto rr=__builtin_amdgcn_permlane32_swap(__float_as_uint(m),__float_as_uint(m),false,false);
  return max2f(__uint_as_float(rr[0]),__uint_as_float(rr[1]));
}
__device__ __forceinline__ void pv(f32x16*o,int vb,bf16x8 pa0,bf16x8 pa1,bf16x8 pa2,bf16x8 pa3){
  #pragma unroll
  for(int d0=0;d0<2;++d0){s16x4 lo[4],hi[4];
    #pragma unroll
    for(int ks=0;ks<4;++ks){
      asm volatile("ds_read_b64_tr_b16 %0,%1 offset:%c2":"=&v"(lo[ks]):"v"(vb),"i"(d0*4096+ks*1024):"memory");
      asm volatile("ds_read_b64_tr_b16 %0,%1 offset:%c2":"=&v"(hi[ks]):"v"(vb),"i"(d0*4096+ks*1024+512):"memory");}
    asm volatile("s_waitcnt lgkmcnt(0)":::"memory");SBAR();
    #define PK(k) (bf16x8){lo[k][0],lo[k][1],lo[k][2],lo[k][3],hi[k][0],hi[k][1],hi[k][2],hi[k][3]}
    o[d0]=__builtin_amdgcn_mfma_f32_32x32x16_bf16(pa0,PK(0),o[d0],0,0,0);
    o[d0]=__builtin_amdgcn_mfma_f32_32x32x16_bf16(pa1,PK(1),o[d0],0,0,0);
    o[d0]=__builtin_amdgcn_mfma_f32_32x32x16_bf16(pa2,PK(2),o[d0],0,0,0);
    o[d0]=__builtin_amdgcn_mfma_f32_32x32x16_bf16(pa3,PK(3),o[d0],0,0,0);
    #undef PK
  }
}

#ifndef ATTN_STORE16
#define ATTN_STORE16(p,v) (*(u32x4*)(p)=(v))
#endif
template<int THRL,bool SPLIT> __device__ __forceinline__ void attn_unit(int b,int h,int qb,int tb_,int NT_,const bf16*QKV,bf16*O,bf16*part_o,float*part_ml,char*shm){
  const int tb=SPLIT?tb_:0, NT=SPLIT?NT_:130;
  int tid_=threadIdx.x; asm volatile("":"+v"(tid_)); const int tid=tid_,lane=tid&63,r32=lane&31,hi=lane>>5; const int wid=__builtin_amdgcn_readfirstlane(tid>>6);
  const bool meta=SPLIT; const int kvh=h>>2;
  const long rowbase=(long)b*SEQR; const long metabase=(long)MROW0+b*16;
  const bf16*Qlane=meta? QKV+(metabase+(r32&15))*PQ+(h+(wid&1)*2+(r32>>4))*D : QKV+(rowbase+qb*QB+wid*QBLK+r32)*PQ+h*D;
  const bf16*Kh=QKV+1024+kvh*D,*Vh=QKV+1280+kvh*D;
  #define TROW(t) ((tb+(t))<128?rowbase+(long)(tb+(t))*KVBLK:metabase)
  const unsigned lds0=(unsigned)(uintptr_t)shm;
  float*wsf=(float*)(shm+LDS_WS)+wid*64;
  const bf16*ksrc=Kh+(long)lane*PQ+wid*8;
  const bf16*vsrc=Vh+(long)(16*(wid&3)+(lane>>2))*PQ+(wid>>2)*32+(lane&3)*8;
  const unsigned kdst=lds0+LDS_K+wid*1024, vdst=lds0+LDS_V+wid*1024;
  #define DMA_K(t,slot) glds16(ksrc+TROW(t)*PQ,(unsigned)__builtin_amdgcn_readfirstlane(kdst+(slot)))
  #define DMA_V(t,slot) glds16(vsrc+TROW(t)*PQ,(unsigned)__builtin_amdgcn_readfirstlane(vdst+(slot)))
  const int vb0=(int)(lds0+LDS_V)+((lane>>4)&1)*32+(lane&3)*8+(4*hi+((lane&15)>>2))*64;
  const char*Kbase=shm+LDS_K; bf16x8 kf[8];
  const lds_cptr shm3=(lds_cptr)shm; const lds_cptr kp0=shm3+LDS_K+hi*1024+r32*16; const lds_cptr vp0=shm3+LDS_V+((lane>>4)&1)*32+(lane&3)*8+(4*hi+((lane&15)>>2))*64;
  DMA_K(0,0);DMA_V(0,0);DMA_K(1,SLOTB);
  bf16x8 qr[4];
  #pragma unroll
  for(int d0=0;d0<4;++d0)qr[d0]=*reinterpret_cast<const bf16x8*>(&Qlane[d0*16+hi*8]);
  float mhat=0.f,l_reg=0.f;f32x16 o[2];o[0]=f32x16{};o[1]=f32x16{};f32x16 negm=f32x16{};asm volatile("":"+v"(negm));
  #define CMASK(P0,P1,t) do{int jb_=(tb+(t))-128; if(jb_>=0)cmask(P0,P1,jb_,hi);}while(0)
  bool resc=false;
  #define START(P0,P1) do{ const float rm=rowmax(P0,P1); resc=false; \
    { const float dl=rm; mhat=fadd_s(mhat,dl); \
      _Pragma("unroll") for(int r=0;r<16;++r){P0[r]=fsub_s(P0[r],dl);P1[r]=fsub_s(P1[r],dl);} \
      _Pragma("unroll") for(int r=0;r<16;++r)negm[r]=-mhat; asm volatile("":"+v"(negm)); } \
    _Pragma("unroll") for(int r=0;r<16;++r)P0[r]=__builtin_amdgcn_exp2f(P0[r]); }while(0)
  #define RESC() do{ if(resc){ asm volatile("s_waitcnt lgkmcnt(0)":::"memory"); \
      _Pragma("unroll") for(int d_=0;d_<2;++d_) _Pragma("unroll") for(int r=0;r<16;++r)o[d_][r]*=wsf[crow(r,hi)]; } }while(0)
  f32x16 pA0,pA1,pB0,pB1;
  int sl_prev=0,sl_cur=0,sl_next=SLOTB;
  #define ROT() do{sl_prev=sl_cur;sl_cur=sl_next;sl_next=(sl_next==(NSLOT-1)*SLOTB)?0:sl_next+SLOTB;}while(0)
  DMA_K(2,2*SLOTB);
  WAIT_BAR(3);
  qkt(pA0,pA1,Kbase,qr,negm,r32,hi);asm volatile("s_nop 15\n\ts_nop 7":"+v"(pA0),"+v"(pA1));CMASK(pA0,pA1,0);
  START(pA0,pA1);
  _Pragma("unroll") for(int r=0;r<16;++r)pA1[r]=__builtin_amdgcn_exp2f(pA1[r]);
  WAIT_BAR(0);
  DMA_K(3,0);DMA_V(1,SLOTB);
  ROT();
  kload8(kf,kp0+sl_cur);
  WAIT_BAR(2);
  s16x4 vlo[8],vhi[8]; u32x4 pw0,pw1,pw2,pw3;
  #define PKW(P,B) cvtpk_s(P[B],P[B+1])
  #define PAF(k) __builtin_bit_cast(bf16x8,pw##k)
  #define VFR(i) (bf16x8){vlo[i][0],vlo[i][1],vlo[i][2],vlo[i][3],vhi[i][0],vhi[i][1],vhi[i][2],vhi[i][3]}
  #define PIN(x) asm volatile("":"+v"(x))
  #define MX3(a,b,c) __builtin_fmaxf(__builtin_fmaxf((a),(b)),(c))
  #define GAPA(MF,A0,A1,A2,A3,W0,W1,PW) do{ MF; sacc+=A0; sacc+=A1; sacc+=A2; sacc+=A3; PIN(sacc); W0; W1; PIN(PW); SBAR(); }while(0)
  #define EX(v) __builtin_amdgcn_exp2f(v)
  #define GAPB(MF,X,B) do{ MF; X[B]=EX(X[B]); X[B+1]=EX(X[B+1]); X[B+2]=EX(X[B+2]); X[B+3]=EX(X[B+3]); PIN(X); SBAR(); }while(0)
  #define VRD(i) do{ vlo[i]=vtr(vp_+(((i)>>2)*4096+((i)&3)*1024)); vhi[i]=vtr(vp_+(((i)>>2)*4096+((i)&3)*1024+512)); }while(0)
  #define KRD(G,j) do{ if(G){ kload2(kf,kp0+sl_next,j); SBAR(); } }while(0)
  #define STEP(C0,C1,P0,P1,t,GK,GV,GL) do{ SBAR(); \
    const lds_cptr vp_=vp0+sl_prev; \
    VRD(0); SBAR(); float sacc=(P0[0]+P0[1]); \
    GAPA(C0=__builtin_amdgcn_mfma_f32_32x32x16_bf16(kf[0],qr[0],negm,0,0,0), P0[2],P0[3],P0[4],P0[5],     pw0[0]=PKW(P0,0), pw0[1]=PKW(P0,2), pw0); \
    VRD(4); SBAR(); GAPA(C1=__builtin_amdgcn_mfma_f32_32x32x16_bf16(kf[1],qr[0],negm,0,0,0), P0[6],P0[7],P0[8],P0[9],     pw0[2]=PKW(P0,4), pw0[3]=PKW(P0,6), pw0); \
    VRD(1); SBAR(); GAPA(C0=__builtin_amdgcn_mfma_f32_32x32x16_bf16(kf[2],qr[1],C0,0,0,0),   P0[10],P0[11],P0[12],P0[13], pw1[0]=PKW(P0,8), pw1[1]=PKW(P0,10), pw1); \
    VRD(5); SBAR(); GAPA(C1=__builtin_amdgcn_mfma_f32_32x32x16_bf16(kf[3],qr[1],C1,0,0,0),   P0[14],P0[15],P1[0],P1[1],   pw1[2]=PKW(P0,12),pw1[3]=PKW(P0,14), pw1); \
    VRD(2); SBAR(); GAPA(C0=__builtin_amdgcn_mfma_f32_32x32x16_bf16(kf[4],qr[2],C0,0,0,0),   P1[2],P1[3],P1[4],P1[5],     pw2[0]=PKW(P1,0), pw2[1]=PKW(P1,2), pw2); \
    VRD(6); SBAR(); GAPA(C1=__builtin_amdgcn_mfma_f32_32x32x16_bf16(kf[5],qr[2],C1,0,0,0),   P1[6],P1[7],P1[8],P1[9],     pw2[2]=PKW(P1,4), pw2[3]=PKW(P1,6), pw2); \
    VRD(3); SBAR(); GAPA(C0=__builtin_amdgcn_mfma_f32_32x32x16_bf16(kf[6],qr[3],C0,0,0,0),   P1[10],P1[11],P1[12],P1[13], pw3[0]=PKW(P1,8), pw3[1]=PKW(P1,10), pw3); \
    VRD(7); SBAR(); GAPA(C1=__builtin_amdgcn_mfma_f32_32x32x16_bf16(kf[7],qr[3],C1,0,0,0),   P1[14],P1[15],0.f,0.f,       pw3[2]=PKW(P1,12),pw3[3]=PKW(P1,14), pw3); \
    l_reg+=sacc; \
    if(GK){DMA_K((t)+3,sl_cur);} if(GV){DMA_V((t)+1,sl_next);} \
    CMASK(C0,C1,t); \
    { float a=MX3(C0[0],C0[1],C1[0]),b=MX3(C0[2],C0[3],C1[1]); a=MX3(a,C1[2],C1[3]); \
      _Pragma("unroll") for(int r=4;r<16;r+=4){a=MX3(a,C0[r],C0[r+1]);b=MX3(b,C0[r+2],C0[r+3]);a=MX3(a,C1[r],C1[r+1]);b=MX3(b,C1[r+2],C1[r+3]);} \
      float rm=__builtin_fmaxf(a,b); { auto rr=__builtin_amdgcn_permlane32_swap(__float_as_uint(rm),__float_as_uint(rm),false,false); rm=__builtin_fmaxf(__uint_as_float(rr[0]),__uint_as_float(rr[1])); } \
      resc=false; \
      if(__builtin_expect(__any(rm>(float)THRL),0)){ const float dl=__builtin_fmaxf(rm,0.f); mhat+=dl; \
        _Pragma("unroll") for(int r=0;r<16;++r){C0[r]-=dl;C1[r]-=dl;} \
        _Pragma("unroll") for(int r=0;r<16;++r)negm[r]=-mhat; asm volatile("":"+v"(negm)); \
        const float f=__builtin_amdgcn_exp2f(-dl); l_reg*=f; if(hi==0)wsf[r32]=f; resc=true; } } \
    SBAR(); \
    GAPB(o[0]=__builtin_amdgcn_mfma_f32_32x32x16_bf16(PAF(0),VFR(0),o[0],0,0,0), C0,0); \
    GAPB(o[1]=__builtin_amdgcn_mfma_f32_32x32x16_bf16(PAF(0),VFR(4),o[1],0,0,0), C0,4); \
    KRD(GL,0); GAPB(o[0]=__builtin_amdgcn_mfma_f32_32x32x16_bf16(PAF(1),VFR(1),o[0],0,0,0), C0,8); \
    KRD(GL,1); GAPB(o[1]=__builtin_amdgcn_mfma_f32_32x32x16_bf16(PAF(1),VFR(5),o[1],0,0,0), C0,12); \
    KRD(GL,2); GAPB(o[0]=__builtin_amdgcn_mfma_f32_32x32x16_bf16(PAF(2),VFR(2),o[0],0,0,0), C1,0); \
    KRD(GL,3); GAPB(o[1]=__builtin_amdgcn_mfma_f32_32x32x16_bf16(PAF(2),VFR(6),o[1],0,0,0), C1,4); \
    GAPB(o[0]=__builtin_amdgcn_mfma_f32_32x32x16_bf16(PAF(3),VFR(3),o[0],0,0,0), C1,8); \
    GAPB(o[1]=__builtin_amdgcn_mfma_f32_32x32x16_bf16(PAF(3),VFR(7),o[1],0,0,0), C1,12); \
    }while(0)
  int t=1;
  #undef CMASK
  #define CMASK(P0,P1,t) do{}while(0)
  for(;t+5<NT;t+=2){
    STEP(pB0,pB1,pA0,pA1,t,true,true,true);     WAIT_BAR(2); RESC(); ROT();
    STEP(pA0,pA1,pB0,pB1,t+1,true,true,true);   WAIT_BAR(2); RESC(); ROT();
  }
  #undef CMASK
  #define CMASK(P0,P1,t) do{int jb_=(tb+(t))-128; if(jb_>=0)cmask(P0,P1,jb_,hi);}while(0)
  #define ENDW(tt) do{ if((tt)+3<NT){WAIT_BAR(2);} else if((tt)+2<NT){WAIT_BAR(1);} else {WAIT_BAR(0);} }while(0)
  for(;t+1<NT;t+=2){
    STEP(pB0,pB1,pA0,pA1,t,(t+3<NT),(t+1<NT),(t+1<NT));       ENDW(t);   RESC(); ROT();
    STEP(pA0,pA1,pB0,pB1,t+1,(t+4<NT),(t+2<NT),(t+2<NT));     ENDW(t+1); RESC(); ROT();
  }
  STEP(pB0,pB1,pA0,pA1,NT-1,false,false,false); RESC();
  { float sacc=pB0[0]+pB0[1]; _Pragma("unroll") for(int r=2;r<16;++r)sacc+=pB0[r]; _Pragma("unroll") for(int r=0;r<16;++r)sacc+=pB1[r]; l_reg+=sacc;
    pw0=(u32x4){PKW(pB0,0),PKW(pB0,2),PKW(pB0,4),PKW(pB0,6)};pw1=(u32x4){PKW(pB0,8),PKW(pB0,10),PKW(pB0,12),PKW(pB0,14)};pw2=(u32x4){PKW(pB1,0),PKW(pB1,2),PKW(pB1,4),PKW(pB1,6)};pw3=(u32x4){PKW(pB1,8),PKW(pB1,10),PKW(pB1,12),PKW(pB1,14)};
    SBAR(); pv(o,vb0+sl_cur,PAF(0),PAF(1),PAF(2),PAF(3)); }
  #undef PKW
  #undef PAF
  #undef VFR
  #undef PIN
  #undef MX3
  #undef GAPA
  #undef GAPB
  #undef EX
  #undef VRD
  #undef KRD
  #undef STEP
  #undef ENDW
  {auto rr=__builtin_amdgcn_permlane32_swap(__float_as_uint(l_reg),__float_as_uint(l_reg),false,false);l_reg=__uint_as_float(rr[0])+__uint_as_float(rr[1]);}
  if(hi==0)wsf[32+r32]=l_reg;asm volatile("s_waitcnt lgkmcnt(0)":::"memory");
  if(meta&&wid<2&&hi==0){ float*ml=part_ml+((size_t)(((b*4+(tb>>5))*16+(h+wid*2+(r32>>4)))*16+(r32&15)))*2; ml[0]=mhat; ml[1]=l_reg; }
  float rli[16];
  #pragma unroll
  for(int r=0;r<16;++r)rli[r]=__builtin_amdgcn_rcpf(wsf[32+crow(r,hi)]);
  { bf16*stg=(bf16*)(shm+LDS_OST)+wid*2048;
    #pragma unroll
    for(int r=0;r<16;++r){const int orow=crow(r,hi);
      #pragma unroll
      for(int d0=0;d0<2;++d0)stg[orow*64+d0*32+r32]=__float2bfloat16(o[d0][r]*rli[r]);}
    asm volatile("s_waitcnt lgkmcnt(0)":::"memory");
    #pragma unroll
    for(int i=0;i<4;++i){const int row=i*8+(lane>>3),ch=lane&7; const u32x4 v=*(const u32x4*)(stg+row*64+ch*8);
      bf16*op=meta? part_o+((size_t)(((b*4+(tb>>5))*16+(h+(wid&1)*2+(row>>4)))*16+(row&15)))*D+ch*8 : O+(rowbase+qb*QB+wid*QBLK+row)*PO+h*D+ch*8;
      if(!meta||wid<2) ATTN_STORE16(op,v);} }
  asm volatile("s_waitcnt lgkmcnt(0)\n\ts_barrier":::"memory");
  #undef DMA_K
  #undef TROW
  #undef DMA_V
  #undef CMASK
  #undef START
  #undef RESC
  #undef ROT
}
constexpr int ATTN_LDS_BYTES=LDS_BYTES;
#undef SBAR
#undef WAIT_BAR
}
#define LAS __attribute__((address_space(3)))
typedef unsigned short bf16_t;
typedef short bf16x8 __attribute__((ext_vector_type(8)));
typedef float f32x4 __attribute__((ext_vector_type(4)));
typedef float f32x2 __attribute__((ext_vector_type(2)));
typedef unsigned u32x2 __attribute__((ext_vector_type(2)));
typedef unsigned u32x4 __attribute__((ext_vector_type(4)));
typedef __bf16 bf16x2_t __attribute__((ext_vector_type(2)));

#ifndef PROBE_ON
#define PROBE_ON 0
#endif
#ifndef PROBE_A
#define PROBE_A 0x01
#endif
#ifndef PROBE_B
#define PROBE_B 0x10
#endif
#ifndef PG_ALIGN
#define PG_ALIGN true
#endif
#ifndef PG_SP2
#define PG_SP2 true
#endif
constexpr int NTHR = 512, NWAVES = 8;
constexpr int DMODEL = 1024, MR = 32768, NMROWS = 64, MP = 33024, SEQL = 8192, FFH = 2816;
constexpr float RMS_EPS = 1e-6f;
constexpr int LDS_BYTES = 163840;
constexpr size_t MiB = 1u << 20;
constexpr size_t OFF_W_AQKV = 0;
constexpr size_t OFF_W_AO   = 12 * MiB;
constexpr size_t OFF_W_BQKV = 16 * MiB;
constexpr size_t OFF_W_BO   = 19 * MiB;
constexpr size_t OFF_W_CIN  = 21 * MiB;
constexpr size_t OFF_W_CO   = 28 * MiB;
constexpr size_t OFF_W13    = 30 * MiB;
constexpr size_t OFF_W2     = 74 * MiB;
constexpr size_t OFF_HB     = 96 * MiB;
constexpr size_t OFF_AO     = 161 * MiB;
constexpr size_t OFF_QKV    = 226 * MiB;
constexpr size_t OFF_VT     = OFF_QKV + 129 * MiB;
constexpr size_t OFF_HX     = 436 * MiB;
constexpr size_t OFF_SS     = 444 * MiB;
constexpr size_t OFF_GATES  = 439 * MiB;
constexpr size_t OFF_ROPE   = 442 * MiB;
constexpr size_t OFF_TS     = 464 * MiB;
constexpr size_t OFF_BAR    = 465 * MiB;
constexpr size_t BAR_BYTES  = 16384;
constexpr size_t OFF_GSC    = 466 * MiB;
constexpr size_t WS_END     = 500 * MiB;
constexpr int MISC_OFF = LDS_BYTES - 128;

struct Args { const float* in[20]; float* out; unsigned char* ws; int ph_lo, ph_hi; };

__device__ __forceinline__ int opaque_tid() { int t = threadIdx.x; asm volatile("" : "+v"(t)); return t; }
__device__ __forceinline__ unsigned pk2(float lo, float hi) { f32x2 v = {lo, hi}; bf16x2_t b = __builtin_convertvector(v, bf16x2_t); return __builtin_bit_cast(unsigned, b); }
__device__ __forceinline__ float frcp(float x) { return __builtin_amdgcn_rcpf(x); }
__device__ __forceinline__ float silu_f(float x) { return x * frcp(1.f + __expf(-x)); }
__device__ __forceinline__ float bf2f(unsigned short v) { return __uint_as_float(((unsigned)v) << 16); }
__device__ __forceinline__ float bflo(unsigned w) { return __uint_as_float(w << 16); }
__device__ __forceinline__ float bfhi(unsigned w) { return __uint_as_float(w & 0xffff0000u); }
__device__ __forceinline__ f32x4 mfma16(bf16x8 a, bf16x8 b, f32x4 c) { return __builtin_amdgcn_mfma_f32_16x16x32_bf16(a, b, c, 0, 0, 0); }
__device__ __forceinline__ float rstd_of(const float* p16) { const f32x4 a = *(const f32x4*)p16, b = *(const f32x4*)(p16 + 4), c = *(const f32x4*)(p16 + 8), d = *(const f32x4*)(p16 + 12);
    const float ss = (((a[0] + a[1]) + (a[2] + a[3])) + ((b[0] + b[1]) + (b[2] + b[3]))) + (((c[0] + c[1]) + (c[2] + c[3])) + ((d[0] + d[1]) + (d[2] + d[3])));
    return rsqrtf(ss * (1.0f / 1024.0f) + RMS_EPS); }

__device__ __forceinline__ void rstd_rows8(const float* ss, int row0  , int fq, float (&rs)[8]) {
    f32x4 sv[8];
#pragma unroll
    for (int i = 0; i < 8; ++i) sv[i] = *(const f32x4*)(ss + (size_t)(row0 + (i >> 2) * 128 + (i & 3) * 16) * 16 + 4 * fq);
#pragma unroll
    for (int i = 0; i < 8; ++i) { float s = (sv[i][0] + sv[i][1]) + (sv[i][2] + sv[i][3]); s += __shfl_xor(s, 16); s += __shfl_xor(s, 32); rs[i] = rsqrtf(s * (1.0f / 1024.0f) + RMS_EPS); }
}
__device__ __forceinline__ void rstd_cols8(const float* ss, int col0, int fr, int lane, float (&rs)[8]) {
    const f32x4 a = *(const f32x4*)(ss + (size_t)col0 * 16 + 8 * fr), b = *(const f32x4*)(ss + (size_t)col0 * 16 + 8 * fr + 4);
    float s = ((a[0] + a[1]) + (a[2] + a[3])) + ((b[0] + b[1]) + (b[2] + b[3]));
    s += __shfl_xor(s, 1);
    const float r = rsqrtf(s * (1.0f / 1024.0f) + RMS_EPS);
#pragma unroll
    for (int c = 0; c < 8; ++c) rs[c] = __shfl(r, (lane & 48) | (2 * c));
}
struct EpiScaleBf16 {
    static constexpr bool PERM = true, AFTER_DRAIN = false;
    bf16_t* O; int ldc; const float* ss;
    __device__ __forceinline__ void operator()(const pg8::f32x4 (&acc)[2][2][4][2], const pg8::Unit& u, int wr, int wc, int fr_, int fq_) const {
        int fr = fr_, fq = fq_; asm volatile("" : "+v"(fr), "+v"(fq));
        float rsa[8]; rstd_rows8(ss, u.pm * 256 + wr * 64 + fr, fq, rsa);
#pragma unroll
        for (int ai = 0; ai < 2; ++ai)
#pragma unroll
            for (int m = 0; m < 4; ++m) {
                const int row = u.pm * 256 + ai * 128 + wr * 64 + m * 16 + fr;
                const float rs = rsa[ai * 4 + m];
#pragma unroll
                for (int bj = 0; bj < 2; ++bj) {
                    const int col = u.pn * 256 + bj * 128 + wc * 32 + 8 * fq;
                    const pg8::f32x4 v0 = acc[ai][bj][m][0] * rs, v1 = acc[ai][bj][m][1] * rs;
                    u32x4 w; w.x = pk2(v0[0], v0[1]); w.y = pk2(v0[2], v0[3]); w.z = pk2(v1[0], v1[1]); w.w = pk2(v1[2], v1[3]);
                    *(u32x4*)(O + (size_t)row * ldc + col) = w;
                }
            }
    }
};
struct EpiScaleColBf16 {
    static constexpr bool PERM = true, AFTER_DRAIN = false;
    bf16_t* O; int ldc; const float* ss;
    __device__ __forceinline__ void operator()(const pg8::f32x4 (&acc)[2][2][4][2], const pg8::Unit& u, int wr, int wc, int fr_, int fq_) const {
        int fr = fr_, fq = fq_; asm volatile("" : "+v"(fr), "+v"(fq));
#pragma unroll
        for (int bj = 0; bj < 2; ++bj) {
            const int col = u.pn * 256 + bj * 128 + wc * 32 + 8 * fq;
            float rc[8]; rstd_cols8(ss, col, fr, fr + 16 * fq, rc);
            pg8::f32x4 r0, r1; r0[0] = rc[0]; r0[1] = rc[1]; r0[2] = rc[2]; r0[3] = rc[3]; r1[0] = rc[4]; r1[1] = rc[5]; r1[2] = rc[6]; r1[3] = rc[7];
#pragma unroll
            for (int ai = 0; ai < 2; ++ai)
#pragma unroll
                for (int m = 0; m < 4; ++m) {
                    const int row = u.pm * 256 + ai * 128 + wr * 64 + m * 16 + fr;
                    const pg8::f32x4 v0 = acc[ai][bj][m][0] * r0, v1 = acc[ai][bj][m][1] * r1;
                    u32x4 w; w.x = pk2(v0[0], v0[1]); w.y = pk2(v0[2], v0[3]); w.z = pk2(v1[0], v1[1]); w.w = pk2(v1[2], v1[3]);
                    *(u32x4*)(O + (size_t)row * ldc + col) = w;
                }
        }
    }
};
struct EpiResid {
    static constexpr bool PERM = true, AFTER_DRAIN = false;
    bf16_t* HB; float* ssn;
    __device__ __forceinline__ void operator()(const pg8::f32x4 (&acc)[2][2][4][2], const pg8::Unit& u, int wr, int wc, int fr_, int fq_) const {
        int fr = fr_, fq = fq_; asm volatile("" : "+v"(fr), "+v"(fq));
        bf16_t* base = HB + (size_t)(u.pm * 256 + wr * 64 + fr) * 1024 + u.pn * 256 + wc * 32 + 8 * fq;
        u32x4 hw[2][4][2];
#pragma unroll
        for (int ai = 0; ai < 2; ++ai)
#pragma unroll
            for (int m = 0; m < 4; ++m)
#pragma unroll
                for (int bj = 0; bj < 2; ++bj) hw[ai][m][bj] = *(const u32x4*)(base + (size_t)(ai * 128 + m * 16) * 1024 + bj * 128);
#pragma unroll
        for (int ai = 0; ai < 2; ++ai)
#pragma unroll
            for (int m = 0; m < 4; ++m) {
                const int row = u.pm * 256 + ai * 128 + wr * 64 + m * 16 + fr;
                float sq = 0.f;
#pragma unroll
                for (int bj = 0; bj < 2; ++bj) {
                    const u32x4 h = hw[ai][m][bj]; const pg8::f32x4 a0 = acc[ai][bj][m][0], a1 = acc[ai][bj][m][1];
                    const float h0 = bflo(h.x) + a0[0], h1 = bfhi(h.x) + a0[1], h2 = bflo(h.y) + a0[2], h3 = bfhi(h.y) + a0[3];
                    const float h4 = bflo(h.z) + a1[0], h5 = bfhi(h.z) + a1[1], h6 = bflo(h.w) + a1[2], h7 = bfhi(h.w) + a1[3];
                    sq += ((h0 * h0 + h1 * h1) + (h2 * h2 + h3 * h3)) + ((h4 * h4 + h5 * h5) + (h6 * h6 + h7 * h7));
                    u32x4 w; w.x = pk2(h0, h1); w.y = pk2(h2, h3); w.z = pk2(h4, h5); w.w = pk2(h6, h7);
                    *(u32x4*)(base + (size_t)(ai * 128 + m * 16) * 1024 + bj * 128) = w;
                }
                sq += __shfl_xor(sq, 16); sq += __shfl_xor(sq, 32);
                if (fq == 0) ssn[(size_t)row * 16 + u.pn * 4 + wc] = sq;
            }
    }
};
struct EpiSwiglu {
    static constexpr bool PERM = true, AFTER_DRAIN = false;
    bf16_t* O; const float* ss;
    __device__ __forceinline__ void operator()(const pg8::f32x4 (&acc)[2][2][4][2], const pg8::Unit& u, int wr, int wc, int fr_, int fq_) const {
        int fr = fr_, fq = fq_; asm volatile("" : "+v"(fr), "+v"(fq));
        float rsa[8]; rstd_rows8(ss, u.pm * 256 + wr * 64 + fr, fq, rsa);
#pragma unroll
        for (int ai = 0; ai < 2; ++ai)
#pragma unroll
            for (int m = 0; m < 4; ++m) {
                const int row = u.pm * 256 + ai * 128 + wr * 64 + m * 16 + fr;
                const float rs = rsa[ai * 4 + m];
#pragma unroll
                for (int bj = 0; bj < 2; ++bj) {
                    const int col = u.pn * 256 + bj * 128 + wc * 32 + 8 * fq;
                    const pg8::f32x4 v0 = acc[ai][bj][m][0] * rs, v1 = acc[ai][bj][m][1] * rs;
                    const float h0 = silu_f(v0[0]) * v0[1], h1 = silu_f(v0[2]) * v0[3];
                    const float h2 = silu_f(v1[0]) * v1[1], h3 = silu_f(v1[2]) * v1[3];
                    u32x2 w; w.x = pk2(h0, h1); w.y = pk2(h2, h3);
                    *(u32x2*)(O + (size_t)row * FFH + (col >> 1)) = w;
                }
            }
    }
};
typedef __attribute__((address_space(1))) unsigned gu32;
#define XB_TMO      128
#define XB_XCNT(j)  (256  + 64 * (j))
#define XB_XSUB(j)  (1280 + 64 * (j))
#define XB_XGEN(j)  (2304 + 64 * (j))
#define XB_TOP      3328
#define XB_TOPGEN   3392
#define XCD_BAR_WORDS 3456
#define XB_SPIN_CAP (1u << 18)

__device__ __forceinline__ unsigned xb_ld(unsigned* p)              { return __hip_atomic_load(p, __ATOMIC_RELAXED, __HIP_MEMORY_SCOPE_AGENT); }
__device__ __forceinline__ unsigned xb_add(unsigned* p, unsigned v) { return __hip_atomic_fetch_add(p, v, __ATOMIC_RELAXED, __HIP_MEMORY_SCOPE_AGENT); }
__device__ __forceinline__ unsigned xb_xcc_id() { return (unsigned)__builtin_amdgcn_s_getreg((3 << 11) | 20) & 0xFu; }
#define XB_SPIN(cond, bar) do { unsigned _sp = 0; while (cond) { __builtin_amdgcn_s_sleep(1); \
    if ((++_sp & 255u) == 0u) { if (xb_ld(&(bar)[XB_TMO])) break; if (_sp > XB_SPIN_CAP) { atomicAdd(&(bar)[XB_TMO], 1u); break; } } } } while (0)

struct XcdBarrier {
    unsigned* bar; unsigned x;
    volatile LAS unsigned* st;
};

__device__ __forceinline__ XcdBarrier xcd_barrier_post(unsigned* bar, volatile LAS unsigned* st) {
    XcdBarrier b; b.bar = bar; b.x = xb_xcc_id(); b.st = st;
    if (threadIdx.x == 0) (void)xb_add(&bar[XB_XCNT(b.x)], 1u);
    return b;
}
__device__ __forceinline__ void xcd_barrier_complete(unsigned* bar, unsigned x, unsigned& nloc, unsigned& nx) {
    const unsigned G = gridDim.x * gridDim.y * gridDim.z;
    unsigned sum, cnt, mine, sp = 0u;
    for (;;) {
        sum = 0u; cnt = 0u; mine = 0u;
#pragma unroll
        for (unsigned j = 0; j < 16; ++j) { const unsigned c = xb_ld(&bar[XB_XCNT(j)]); sum += c; cnt += (c > 0u) ? 1u : 0u; mine = (j == x) ? c : mine; }
        if (sum == G) break;
        __builtin_amdgcn_s_sleep(1);
        if ((++sp & 255u) == 0u) { if (xb_ld(&bar[XB_TMO])) break; if (sp > XB_SPIN_CAP) { atomicAdd(&bar[XB_TMO], 1u); break; } }
    }
    nloc = mine > 0u ? mine : 1u; nx = cnt > 0u ? cnt : 1u;
}

__device__ __forceinline__ void xcd_barrier(const XcdBarrier& b) {
    asm volatile("s_waitcnt vmcnt(0)" ::: "memory");
    __syncthreads();
    if (threadIdx.x == 0) {
        unsigned* bar = b.bar;
        __builtin_amdgcn_s_waitcnt(0);
        unsigned nloc = b.st[0], nx = b.st[1];
        if (nloc == 0u) { xcd_barrier_complete(bar, b.x, nloc, nx); b.st[0] = nloc; b.st[1] = nx; }
        const unsigned old = xb_add(&bar[XB_XSUB(b.x)], 1u);
        const unsigned gen = old / nloc;
        if (old + 1u == (gen + 1u) * nloc) {
            __builtin_amdgcn_fence(__ATOMIC_RELEASE, "agent");
            asm volatile("s_waitcnt vmcnt(0)" ::: "memory");
            const unsigned og = xb_add(&bar[XB_TOP], 1u);
            const unsigned tg = og / nx;
            if (og + 1u == (tg + 1u) * nx) xb_add(&bar[XB_TOPGEN], 1u);
            else XB_SPIN(xb_ld(&bar[XB_TOPGEN]) == tg, bar);
            __builtin_amdgcn_fence(__ATOMIC_ACQUIRE, "agent");
            xb_add(&bar[XB_XGEN(b.x)], 1u);
            asm volatile("s_waitcnt vmcnt(0)" ::: "memory");
        } else {
            XB_SPIN(xb_ld(&bar[XB_XGEN(b.x)]) == gen, bar);
            __builtin_amdgcn_fence(__ATOMIC_ACQUIRE, "agent");
            asm volatile("s_waitcnt vmcnt(0)" ::: "memory");
        }
    }
    __syncthreads();
}
enum { SE_SCALE = 0, SE_SCALECOL = 1, SE_RESID = 2, SE_SWIGLU = 3 };
struct StripEpi { int mode; bf16_t* O; int ldc; const float* ss; float* Hx; bf16_t* HB; float* ssn; };
__device__ __forceinline__ void strip_phase(LAS unsigned char* lds, const bf16_t* __restrict__ X, const bf16_t* __restrict__ Y, int K, int njobs, bool swapped, const StripEpi E) {
    const int tid = opaque_tid(), lane = tid & 63, wave = tid >> 6, l16 = lane & 15, g = lane >> 4;
    LAS float* part = (LAS float*)lds;
    const int kw = K >> 3;
    for (int jb = blockIdx.x; jb < njobs; jb += gridDim.x) {
        const int xr0 = swapped ? 64 * jb : 0, yr0 = swapped ? 0 : 64 * jb;
        const bf16_t* xp = X + (size_t)(xr0 + l16) * K + wave * kw + 8 * g;
        const bf16_t* yp = Y + (size_t)(yr0 + l16) * K + wave * kw + 8 * g;
        f32x4 acc[4][4];
#pragma unroll
        for (int a = 0; a < 4; ++a)
#pragma unroll
            for (int b = 0; b < 4; ++b) acc[a][b] = (f32x4){0.f, 0.f, 0.f, 0.f};
#pragma unroll 4
        for (int k = 0; k < kw; k += 32) {
            bf16x8 af[4], bf[4];
#pragma unroll
            for (int a = 0; a < 4; ++a) { af[a] = *(const bf16x8*)(xp + (size_t)a * 16 * K + k); bf[a] = *(const bf16x8*)(yp + (size_t)a * 16 * K + k); }
#pragma unroll
            for (int a = 0; a < 4; ++a)
#pragma unroll
                for (int b = 0; b < 4; ++b) acc[a][b] = mfma16(af[a], bf[b], acc[a][b]);
        }
#pragma unroll
        for (int a = 0; a < 4; ++a)
#pragma unroll
            for (int b = 0; b < 4; ++b)
#pragma unroll
                for (int e = 0; e < 4; ++e) part[wave * 4096 + (16 * a + 4 * g + e) * 64 + 16 * b + l16] = acc[a][b][e];
        __syncthreads();
        const int r = tid >> 3, c0 = (tid & 7) * 8;
        f32x4 s0 = (f32x4){0.f, 0.f, 0.f, 0.f}, s1 = s0;
#pragma unroll
        for (int w = 0; w < 8; ++w) { const f32x4 p0 = *(const LAS f32x4*)(part + w * 4096 + r * 64 + c0), p1 = *(const LAS f32x4*)(part + w * 4096 + r * 64 + c0 + 4);
            s0[0] += p0[0]; s0[1] += p0[1]; s0[2] += p0[2]; s0[3] += p0[3]; s1[0] += p1[0]; s1[1] += p1[1]; s1[2] += p1[2]; s1[3] += p1[3]; }
        if (E.mode == SE_SCALE) {
            const int row = MR + r; const float rs = rstd_of(E.ss + (size_t)row * 16);
            u32x4 o; o.x = pk2(s0[0] * rs, s0[1] * rs); o.y = pk2(s0[2] * rs, s0[3] * rs); o.z = pk2(s1[0] * rs, s1[1] * rs); o.w = pk2(s1[2] * rs, s1[3] * rs);
            *(u32x4*)(E.O + (size_t)row * E.ldc + 64 * jb + c0) = o;
        } else if (E.mode == SE_SCALECOL) {
            const int f = 64 * jb + r, t0 = MR + c0; float rs[8];
#pragma unroll
            for (int i = 0; i < 8; ++i) rs[i] = rstd_of(E.ss + (size_t)(t0 + i) * 16);
            u32x4 o; o.x = pk2(s0[0] * rs[0], s0[1] * rs[1]); o.y = pk2(s0[2] * rs[2], s0[3] * rs[3]); o.z = pk2(s1[0] * rs[4], s1[1] * rs[5]); o.w = pk2(s1[2] * rs[6], s1[3] * rs[7]);
            *(u32x4*)(E.O + (size_t)f * E.ldc + t0) = o;
        } else if (E.mode == SE_RESID) {
            const u32x4 hw = *(const u32x4*)(E.HB + (size_t)(MR + r) * 1024 + 64 * jb + c0);
            f32x4 h0, h1; h0[0] = bflo(hw.x) + s0[0]; h0[1] = bfhi(hw.x) + s0[1]; h0[2] = bflo(hw.y) + s0[2]; h0[3] = bfhi(hw.y) + s0[3]; h1[0] = bflo(hw.z) + s1[0]; h1[1] = bfhi(hw.z) + s1[1]; h1[2] = bflo(hw.w) + s1[2]; h1[3] = bfhi(hw.w) + s1[3];
            u32x4 o; o.x = pk2(h0[0], h0[1]); o.y = pk2(h0[2], h0[3]); o.z = pk2(h1[0], h1[1]); o.w = pk2(h1[2], h1[3]);
            *(u32x4*)(E.HB + (size_t)(MR + r) * 1024 + 64 * jb + c0) = o;
            float sq = ((h0[0] * h0[0] + h0[1] * h0[1]) + (h0[2] * h0[2] + h0[3] * h0[3])) + ((h1[0] * h1[0] + h1[1] * h1[1]) + (h1[2] * h1[2] + h1[3] * h1[3]));
            sq += __shfl_xor(sq, 1); sq += __shfl_xor(sq, 2); sq += __shfl_xor(sq, 4);
            if ((tid & 7) == 0) E.ssn[(size_t)(MR + r) * 16 + jb] = sq;
        } else {
            const int row = MR + r; const float rs = rstd_of(E.ss + (size_t)row * 16);
            const float g0 = s0[0] * rs, g1 = s0[2] * rs, g2 = s1[0] * rs, g3 = s1[2] * rs;
            const float o0 = silu_f(g0) * (s0[1] * rs), o1 = silu_f(g1) * (s0[3] * rs), o2 = silu_f(g2) * (s1[1] * rs), o3 = silu_f(g3) * (s1[3] * rs);
            u32x2 o; o.x = pk2(o0, o1); o.y = pk2(o2, o3);
            *(u32x2*)(E.O + (size_t)row * FFH + ((64 * jb + c0) >> 1)) = o;
        }
        __syncthreads();
    }
}
__device__ __forceinline__ void gates_phase(const bf16_t* __restrict__ HB, const bf16_t* __restrict__ Wg, const float* __restrict__ ss, float* __restrict__ gates) {
    const int tid = opaque_tid(), lane = tid & 63, wave = tid >> 6, l16 = lane & 15, g = lane >> 4;
    const int gw = blockIdx.x * NWAVES + wave, NGW = gridDim.x * NWAVES;
    for (int rt = gw; rt < (MR + NMROWS) / 16; rt += NGW) {
        const bf16_t* xp = HB + (size_t)(16 * rt + l16) * 1024 + 8 * g; const bf16_t* yp = Wg + (size_t)l16 * 1024 + 8 * g;
        f32x4 acc = (f32x4){0.f, 0.f, 0.f, 0.f};
        for (int k0 = 0; k0 < 1024; k0 += 256) {
            bf16x8 af[8], bf[8];
#pragma unroll
            for (int i = 0; i < 8; ++i) { af[i] = *(const bf16x8*)(xp + k0 + 32 * i); bf[i] = *(const bf16x8*)(yp + k0 + 32 * i); }
#pragma unroll
            for (int i = 0; i < 8; ++i) acc = mfma16(af[i], bf[i], acc);
        }
#pragma unroll
        for (int e = 0; e < 4; ++e) { const int row = 16 * rt + 4 * g + e; gates[(size_t)row * 16 + l16] = acc[e] * rstd_of(ss + (size_t)row * 16); }
    }
}
__device__ __forceinline__ float wave_sum(float v) {
#pragma unroll
    for (int o = 1; o < 64; o <<= 1) v += __shfl_xor(v, o);
    return v;
}
__device__ __forceinline__ void transpose_item(const float* W, int Npitch, int K, int nblk, const float* g, bf16_t* WT, int row_off, int row_mul, LAS float* scr, int item, int lane) {
    const int kb = item / nblk, nb = item % nblk, k0 = 64 * kb, n0 = 32 * nb;
    float wv[32];
#pragma unroll
    for (int i = 0; i < 32; ++i) wv[i] = __builtin_nontemporal_load(W + (size_t)(k0 + 2 * i + (lane >> 5)) * Npitch + n0 + (lane & 31));
#pragma unroll
    for (int i = 0; i < 32; ++i) { const int kk = 2 * i + (lane >> 5); const float gv = g ? g[k0 + kk] : 1.f; scr[kk * 33 + (lane & 31)] = wv[i] * gv; }
    asm volatile("s_waitcnt lgkmcnt(0)" ::: "memory");
    const int c = lane & 7;
#pragma unroll
    for (int j = 0; j < 4; ++j) { const int n = (lane >> 3) + 8 * j; const LAS float* s = scr + (8 * c) * 33 + n;
        u32x4 o; o.x = pk2(s[0 * 33], s[1 * 33]); o.y = pk2(s[2 * 33], s[3 * 33]); o.z = pk2(s[4 * 33], s[5 * 33]); o.w = pk2(s[6 * 33], s[7 * 33]);
        *(u32x4*)(WT + (size_t)(row_off + (n0 + n) * row_mul) * K + k0 + 8 * c) = o; }
    asm volatile("s_waitcnt lgkmcnt(0)" ::: "memory");
}
template <int PART>
__device__ __forceinline__ void weight_items(const Args& a, LAS unsigned char* lds, int blk, int nblk) {
    const int tid = opaque_tid(), lane = tid & 63, wave = tid >> 6;
    const int gw = blk * NWAVES + wave, NGW = nblk * NWAVES;
    LAS float* scr = (LAS float*)(lds + wave * 16384);
    unsigned char* ws = a.ws;
    const float* nmix = a.in[2]; const float* nffn = a.in[3];
    constexpr int I_AQKV = 16 * 96, I_SQ = 16 * 32, I_BQKV = 16 * 48, I_CIN = 16 * 96, I_W1 = 16 * 88, I_W2 = 44 * 32, I_FFN = 2 * I_W1 + I_W2;
    constexpr int NITEMS = (PART == 0) ? (I_AQKV + I_SQ + I_BQKV + I_SQ + 2 * I_FFN) : (I_AQKV + I_SQ + I_CIN + I_SQ + 2 * I_FFN);
    for (int it = gw; it < NITEMS; it += NGW) {
        int r = it;
#define TRI(NIT, W, NP, KK, NBLK, G, WT, RO, RM) if (r < (NIT)) { transpose_item(W, NP, KK, NBLK, G, (bf16_t*)(WT), RO, RM, scr, r, lane); continue; } r -= (NIT);
        if (PART == 0) {
            TRI(I_AQKV, a.in[5], 3072, 1024, 96, nmix, ws + OFF_W_AQKV, 0, 1)
            TRI(I_SQ, a.in[8], 1024, 1024, 32, nullptr, ws + OFF_W_AO, 0, 1)
            TRI(I_BQKV, a.in[9], 1536, 1024, 48, nmix + 1024, ws + OFF_W_BQKV, 0, 1)
            TRI(I_SQ, a.in[12], 1024, 1024, 32, nullptr, ws + OFF_W_BO, 0, 1)
        } else {
            TRI(I_AQKV, a.in[5] + (size_t)1024 * 3072, 3072, 1024, 96, nmix + 3 * 1024, ws + OFF_W_AQKV + 6 * MiB, 0, 1)
            TRI(I_SQ, a.in[8] + (size_t)1024 * 1024, 1024, 1024, 32, nullptr, ws + OFF_W_AO + 2 * MiB, 0, 1)
            TRI(I_CIN, a.in[13], 3088, 1024, 96, nmix + 2048, ws + OFF_W_CIN, 0, 1)
            TRI(I_SQ, a.in[16], 1024, 1024, 32, nullptr, ws + OFF_W_CO, 0, 1)
        }
        { const int li = 2 * PART + r / I_FFN; r -= (li - 2 * PART) * I_FFN;
          TRI(I_W1, a.in[17] + (size_t)li * 1024 * FFH, FFH, 1024, 88, nffn + li * 1024, ws + OFF_W13 + (size_t)li * 11 * MiB, 0, 2)
          TRI(I_W1, a.in[18] + (size_t)li * 1024 * FFH, FFH, 1024, 88, nffn + li * 1024, ws + OFF_W13 + (size_t)li * 11 * MiB, 1, 2)
          transpose_item(a.in[19] + (size_t)li * FFH * 1024, 1024, FFH, 32, nullptr, (bf16_t*)(ws + OFF_W2 + (size_t)li * 11 * MiB / 2), 0, 1, scr, r, lane); }
#undef TRI
    }
    if (PART == 1) {
        bf16_t* wc = (bf16_t*)(ws + OFF_W_CIN); const float* W = a.in[13]; const float* g = nmix + 2048;
        if (blk < 16) {
            const int n = 3072 + blk;
#pragma unroll
            for (int q = 0; q < 2; ++q) { const int k = tid + NTHR * q; wc[(size_t)n * 1024 + k] = (bf16_t)(pk2(W[(size_t)k * 3088 + n] * g[k], 0.f) & 0xffffu); } }
    }
}
__device__ __forceinline__ void prologue_phase(const Args& a, LAS unsigned char* lds) {
    weight_items<0>(a, lds, blockIdx.x, gridDim.x);
    const int tid = opaque_tid(), lane = tid & 63, wave = tid >> 6;
    const int gw = blockIdx.x * NWAVES + wave, NGW = gridDim.x * NWAVES;
    unsigned char* ws = a.ws;
    const int gt = blockIdx.x * NTHR + tid, NGT = gridDim.x * NTHR;
    { f32x2* tab = (f32x2*)(ws + OFF_ROPE);
      for (int i = gt; i < 128 * 16; i += NGT) { const int pos = i >> 4, fi = i & 15; const float freq = 1.0f / powf(10000.0f, (float)fi * (1.0f / 16.0f)); const float ang = (float)pos * freq;
          const double tw = 6.283185307179586476925; const double rr = (double)ang - tw * rint((double)ang / tw); const float rf = (float)rr;
          tab[i] = (f32x2){__cosf(rf), __sinf(rf)}; } }
    { float* ss0 = (float*)(ws + OFF_SS); bf16_t* HB = (bf16_t*)(ws + OFF_HB); bf16_t* AO = (bf16_t*)(ws + OFF_AO);
      for (int row0 = gw; row0 < MR; row0 += 4 * NGW) {
          f32x4 v[4][4];
#pragma unroll
          for (int q = 0; q < 4; ++q) { const int row = row0 + q * NGW;
#pragma unroll
              for (int j = 0; j < 4; ++j) v[q][j] = (row < MR) ? __builtin_nontemporal_load((const f32x4*)(a.in[0] + (size_t)row * 1024 + 256 * j + 4 * lane)) : (f32x4){0.f, 0.f, 0.f, 0.f}; }
#pragma unroll
          for (int q = 0; q < 4; ++q) { const int row = row0 + q * NGW; if (row < MR) { float s = 0.f;
#pragma unroll
              for (int j = 0; j < 4; ++j) { const f32x4 x = v[q][j]; s += (x[0] * x[0] + x[1] * x[1]) + (x[2] * x[2] + x[3] * x[3]);
                  u32x2 w; w.x = pk2(x[0], x[1]); w.y = pk2(x[2], x[3]); *(u32x2*)(HB + (size_t)row * 1024 + 256 * j + 4 * lane) = w; }
              s = wave_sum(s); if (lane < 16) ss0[(size_t)row * 16 + lane] = (lane == 0) ? s : 0.f; } } }
      for (int row = MR + gw; row < MP; row += NGW) {
          const bool meta = row < MR + NMROWS;
          const float* src = a.in[1] + (size_t)((row - MR) & 15) * 1024;
          float s = 0.f;
#pragma unroll
          for (int j = 0; j < 4; ++j) { f32x4 v = (f32x4){0.f, 0.f, 0.f, 0.f}; if (meta) v = *(const f32x4*)(src + 256 * j + 4 * lane);
              s += (v[0] * v[0] + v[1] * v[1]) + (v[2] * v[2] + v[3] * v[3]);
              u32x2 w; w.x = pk2(v[0], v[1]); w.y = pk2(v[2], v[3]); *(u32x2*)(HB + (size_t)row * 1024 + 256 * j + 4 * lane) = w;
              if (!meta) *(u32x2*)(AO + (size_t)row * 1024 + 256 * j + 4 * lane) = (u32x2){0u, 0u}; }
          s = wave_sum(s); if (lane < 16) ss0[(size_t)row * 16 + lane] = (lane == 0) ? s : 0.f; } }
}

template <bool META>
__device__ __forceinline__ void na_unit(const bf16_t* __restrict__ QK, const bf16_t* __restrict__ VT, const float* __restrict__ relb, const float* __restrict__ metab, bf16_t* __restrict__ AO, int b, int h, int r, int j, int lane) {
    const int l16 = lane & 15, g = lane >> 4;
    const int qcol = META ? 0 : 16 * j + l16;
    const long mrow0 = (long)MR + b * 16;
    const long qrow = META ? mrow0 + l16 : (long)b * SEQL + r * 64 + qcol;
    const bf16_t* qp = QK + qrow * 2048 + h * 64 + 8 * g;
    const bf16x8 qf0 = *(const bf16x8*)qp, qf1 = *(const bf16x8*)(qp + 32);
    f32x4 sm;
    { const bf16_t* kp = QK + (mrow0 + l16) * 2048 + 1024 + h * 64 + 8 * g;
      const bf16x8 k0 = *(const bf16x8*)kp, k1 = *(const bf16x8*)(kp + 32);
      f32x4 acc = (f32x4){0.f, 0.f, 0.f, 0.f}; acc = mfma16(k0, qf0, acc); acc = mfma16(k1, qf1, acc);
#pragma unroll
      for (int e = 0; e < 4; ++e) sm[e] = acc[e] * 0.125f + metab[4 * g + e]; }
    float mx = fmaxf(fmaxf(sm[0], sm[1]), fmaxf(sm[2], sm[3]));
    f32x4 s[8][2];
    const int kstart = (j == 0) ? 0 : (j == 1) ? 8 : (j == 2) ? 24 : 32;
    const int rs = min(max(r - 4, 0), 120);
    if (!META) {
        const int qs = min(max(qcol - 8, 0), 48);
        const int kc0 = kstart + 8 * (l16 >> 2) + (l16 & 3);
#pragma unroll
        for (int i = 0; i < 8; ++i) {
            const long krow = (long)b * SEQL + (rs + i) * 64;
            const bf16_t* kp0 = QK + (krow + kc0) * 2048 + 1024 + h * 64 + 8 * g;
            const bf16_t* kp1 = kp0 + 4 * 2048;
            f32x4 a0 = (f32x4){0.f, 0.f, 0.f, 0.f}, a1 = (f32x4){0.f, 0.f, 0.f, 0.f};
            a0 = mfma16(*(const bf16x8*)kp0, qf0, a0); a0 = mfma16(*(const bf16x8*)(kp0 + 32), qf1, a0);
            a1 = mfma16(*(const bf16x8*)kp1, qf0, a1); a1 = mfma16(*(const bf16x8*)(kp1 + 32), qf1, a1);
            const float* rb = relb + (rs + i - r + 7) * 31;
#pragma unroll
            for (int e = 0; e < 4; ++e) {
                const int kc = kstart + 8 * g + e, kd = kc + 4;
                const bool v0 = (kc >= qs) && (kc < qs + 16), v1 = (kd >= qs) && (kd < qs + 16);
                const int dc0 = min(max(kc - qcol + 15, 0), 30), dc1 = min(max(kd - qcol + 15, 0), 30);
                const float b0 = rb[dc0], b1 = rb[dc1];
                s[i][0][e] = v0 ? a0[e] * 0.125f + b0 : -INFINITY;
                s[i][1][e] = v1 ? a1[e] * 0.125f + b1 : -INFINITY;
                mx = fmaxf(mx, fmaxf(s[i][0][e], s[i][1][e]));
            }
        }
    }
    mx = fmaxf(mx, __shfl_xor(mx, 16)); mx = fmaxf(mx, __shfl_xor(mx, 32));
    float sum = 0.f;
#pragma unroll
    for (int e = 0; e < 4; ++e) { sm[e] = __expf(sm[e] - mx); sum += sm[e]; }
    if (!META) {
#pragma unroll
        for (int i = 0; i < 8; ++i)
#pragma unroll
            for (int e = 0; e < 4; ++e) { s[i][0][e] = __expf(s[i][0][e] - mx); s[i][1][e] = __expf(s[i][1][e] - mx); sum += s[i][0][e] + s[i][1][e]; }
    }
    sum += __shfl_xor(sum, 16); sum += __shfl_xor(sum, 32);
    const float inv = 1.0f / sum;
    f32x4 o[4];
#pragma unroll
    for (int dt = 0; dt < 4; ++dt) o[dt] = (f32x4){0.f, 0.f, 0.f, 0.f};
    if (!META) {
#pragma unroll
        for (int i = 0; i < 8; ++i) {
            u32x4 pw; pw.x = pk2(s[i][0][0] * inv, s[i][0][1] * inv); pw.y = pk2(s[i][0][2] * inv, s[i][0][3] * inv); pw.z = pk2(s[i][1][0] * inv, s[i][1][1] * inv); pw.w = pk2(s[i][1][2] * inv, s[i][1][3] * inv);
            const bf16x8 pf = __builtin_bit_cast(bf16x8, pw);
            const size_t tok = (size_t)b * SEQL + (rs + i) * 64 + kstart + 8 * g;
#pragma unroll
            for (int dt = 0; dt < 4; ++dt) { const bf16x8 vf = *(const bf16x8*)(VT + (size_t)(h * 64 + dt * 16 + l16) * MP + tok); o[dt] = mfma16(vf, pf, o[dt]); }
        }
    }
    { u32x4 pw; pw.x = pk2(sm[0] * inv, sm[1] * inv); pw.y = pk2(sm[2] * inv, sm[3] * inv); pw.z = 0u; pw.w = 0u;
      const bf16x8 pf = __builtin_bit_cast(bf16x8, pw);
#pragma unroll
      for (int dt = 0; dt < 4; ++dt) { const u32x2 v2 = *(const u32x2*)(VT + (size_t)(h * 64 + dt * 16 + l16) * MP + mrow0 + 4 * g);
          u32x4 vw; vw.x = v2.x; vw.y = v2.y; vw.z = 0u; vw.w = 0u; o[dt] = mfma16(__builtin_bit_cast(bf16x8, vw), pf, o[dt]); } }
#pragma unroll
    for (int dt = 0; dt < 4; ++dt) { u32x2 w; w.x = pk2(o[dt][0], o[dt][1]); w.y = pk2(o[dt][2], o[dt][3]); *(u32x2*)(AO + qrow * 1024 + h * 64 + dt * 16 + 4 * g) = w; }
}
constexpr int NA_KP = 72, NA_VP = 584, NA_SVT = 576 * NA_KP * 2, NA_SB = NA_SVT + 64 * NA_VP * 2;
__device__ __forceinline__ void na_unit_lds(LAS unsigned char* lds, bf16_t* __restrict__ AO, int b, int h, int r, int j, int lane, bf16x8 qf0, bf16x8 qf1, bf16x8 mk0, bf16x8 mk1, const u32x2 (&mv)[4]) {
    const LAS bf16_t* sK = (const LAS bf16_t*)lds; const LAS bf16_t* sVt = (const LAS bf16_t*)(lds + NA_SVT); const LAS float* sB = (const LAS float*)(lds + NA_SB);
    const int l16 = lane & 15, g = lane >> 4;
    const float QS2 = 0.125f * 1.4426950408889634f;
    const int qcol = 16 * j + l16;
    const long mrow0 = (long)MR + b * 16;
    const long qrow = (long)b * SEQL + r * 64 + qcol;
    f32x4 sm;
    { f32x4 acc = (f32x4){0.f, 0.f, 0.f, 0.f}; acc = mfma16(mk0, qf0, acc); acc = mfma16(mk1, qf1, acc);
#pragma unroll
      for (int e = 0; e < 4; ++e) sm[e] = acc[e] * QS2 + sB[465 + 4 * g + e]; }
    float mx = fmaxf(fmaxf(sm[0], sm[1]), fmaxf(sm[2], sm[3]));
    f32x4 s[8][2];
    const int kstart = (j == 0) ? 0 : (j == 1) ? 8 : (j == 2) ? 24 : 32;
    const int rs = min(max(r - 4, 0), 120), rs9 = rs % 9;
    const int qs = min(max(qcol - 8, 0), 48);
    const int kc0 = kstart + 8 * (l16 >> 2) + (l16 & 3);
    const int kb = kstart + 8 * g, dcb = kb - qcol + 15;
    float msk[8];
#pragma unroll
    for (int c = 0; c < 8; ++c) msk[c] = ((kb + c >= qs) && (kb + c < qs + 16)) ? INFINITY : -INFINITY;
#pragma unroll
    for (int i = 0; i < 8; ++i) {
        const int sl = (rs9 + i >= 9) ? rs9 + i - 9 : rs9 + i;
        const LAS bf16_t* kp0 = sK + (sl * 64 + kc0) * NA_KP + 8 * g;
        const LAS bf16_t* kp1 = kp0 + 4 * NA_KP;
        f32x4 a0 = (f32x4){0.f, 0.f, 0.f, 0.f}, a1 = (f32x4){0.f, 0.f, 0.f, 0.f};
        a0 = mfma16(*(const LAS bf16x8*)kp0, qf0, a0); a0 = mfma16(*(const LAS bf16x8*)(kp0 + 32), qf1, a0);
        a1 = mfma16(*(const LAS bf16x8*)kp1, qf0, a1); a1 = mfma16(*(const LAS bf16x8*)(kp1 + 32), qf1, a1);
        const LAS float* rb = sB + (rs + i - r + 7) * 31 + dcb;
#pragma unroll
        for (int e = 0; e < 4; ++e) {
            const float b0 = rb[e], b1 = rb[4 + e];
            s[i][0][e] = fminf(a0[e] * QS2 + b0, msk[e]);
            s[i][1][e] = fminf(a1[e] * QS2 + b1, msk[4 + e]);
            mx = fmaxf(mx, fmaxf(s[i][0][e], s[i][1][e]));
        }
    }
    mx = fmaxf(mx, __shfl_xor(mx, 16)); mx = fmaxf(mx, __shfl_xor(mx, 32));
    float sum = 0.f;
#pragma unroll
    for (int e = 0; e < 4; ++e) { sm[e] = __builtin_amdgcn_exp2f(sm[e] - mx); sum += sm[e]; }
#pragma unroll
    for (int i = 0; i < 8; ++i)
#pragma unroll
        for (int e = 0; e < 4; ++e) { s[i][0][e] = __builtin_amdgcn_exp2f(s[i][0][e] - mx); s[i][1][e] = __builtin_amdgcn_exp2f(s[i][1][e] - mx); sum += s[i][0][e] + s[i][1][e]; }
    sum += __shfl_xor(sum, 16); sum += __shfl_xor(sum, 32);
    const float inv = 1.0f / sum;
    f32x4 o[4];
#pragma unroll
    for (int dt = 0; dt < 4; ++dt) o[dt] = (f32x4){0.f, 0.f, 0.f, 0.f};
#pragma unroll
    for (int i = 0; i < 8; ++i) {
        u32x4 pw; pw.x = pk2(s[i][0][0], s[i][0][1]); pw.y = pk2(s[i][0][2], s[i][0][3]); pw.z = pk2(s[i][1][0], s[i][1][1]); pw.w = pk2(s[i][1][2], s[i][1][3]);
        const bf16x8 pf = __builtin_bit_cast(bf16x8, pw);
        const int sl = (rs9 + i >= 9) ? rs9 + i - 9 : rs9 + i;
        const int tk = sl * 64 + kstart + 8 * g;
#pragma unroll
        for (int dt = 0; dt < 4; ++dt) { const bf16x8 vf = *(const LAS bf16x8*)(sVt + (dt * 16 + l16) * NA_VP + tk); o[dt] = mfma16(vf, pf, o[dt]); }
    }
    { u32x4 pw; pw.x = pk2(sm[0], sm[1]); pw.y = pk2(sm[2], sm[3]); pw.z = 0u; pw.w = 0u;
      const bf16x8 pf = __builtin_bit_cast(bf16x8, pw);
#pragma unroll
      for (int dt = 0; dt < 4; ++dt) { u32x4 vw; vw.x = mv[dt].x; vw.y = mv[dt].y; vw.z = 0u; vw.w = 0u; o[dt] = mfma16(__builtin_bit_cast(bf16x8, vw), pf, o[dt]); } }
#pragma unroll
    for (int dt = 0; dt < 4; ++dt) { u32x2 w; w.x = pk2(o[dt][0] * inv, o[dt][1] * inv); w.y = pk2(o[dt][2] * inv, o[dt][3] * inv); *(u32x2*)(AO + qrow * 1024 + h * 64 + dt * 16 + 4 * g) = w; }
}
__device__ __forceinline__ void na_phase(LAS unsigned char* lds, const bf16_t* QK, const bf16_t* VT, const float* relb, const float* metab, bf16_t* AO) {
    const int tid = opaque_tid(), lane = tid & 63, wave = tid >> 6;
    LAS bf16_t* sK = (LAS bf16_t*)lds; LAS bf16_t* sVt = (LAS bf16_t*)(lds + NA_SVT); LAS float* sB = (LAS float*)(lds + NA_SB);
    { int tz = tid; unsigned z; asm volatile("v_mov_b32 %0, 0" : "=v"(z), "+v"(tz));
      if (tz < 64) { LAS unsigned* pz = (LAS unsigned*)(sVt + tz * NA_VP + 576); pz[0] = z; pz[1] = z; pz[2] = z; pz[3] = z; } }
    for (int sg = blockIdx.x; sg < 256; sg += gridDim.x) {
        const int qd = sg & 3, h = (sg >> 2) & 15, b = sg >> 6;
        const size_t tokb = (size_t)b * SEQL;
        const bf16_t* Kg = QK + 1024 + h * 64; const bf16_t* Vg = VT + (size_t)(h * 64) * MP;
        { const int rsA = min(max(32 * qd - 4, 0), 120);
          int t0_ = tid; asm volatile("" : "+v"(t0_));
          if (t0_ < 465) sB[t0_] = relb[h * 465 + t0_] * 1.4426950408889634f; else if (t0_ < 481) sB[t0_] = metab[h * 16 + t0_ - 465] * 1.4426950408889634f;
#pragma unroll 9
          for (int i = 0; i < 9; ++i) { const int q = t0_ + NTHR * i; const int key = q >> 3, ch = q & 7; const int R = rsA + (key >> 6), sl = R % 9;
              const u32x4 v = *(const u32x4*)(Kg + (tokb + (size_t)R * 64 + (key & 63)) * 2048 + ch * 8); *(LAS u32x4*)(sK + (sl * 64 + (key & 63)) * NA_KP + ch * 8) = v; }
#pragma unroll 9
          for (int i = 0; i < 9; ++i) { const int q = t0_ + NTHR * i; const int d = q / 72, c = q - d * 72; const int R = rsA + (c >> 3), sl = R % 9;
              const u32x4 v = *(const u32x4*)(Vg + (size_t)d * MP + tokb + (size_t)R * 64 + (c & 7) * 8); *(LAS u32x4*)(sVt + d * NA_VP + sl * 64 + (c & 7) * 8) = v; }
        }
        const int l16 = lane & 15, g4 = lane >> 4; const long mrow0 = (long)MR + b * 16;
        bf16x8 mk0, mk1; u32x2 mv[4];
        { const bf16_t* kp = QK + (mrow0 + l16) * 2048 + 1024 + h * 64 + 8 * g4; mk0 = *(const bf16x8*)kp; mk1 = *(const bf16x8*)(kp + 32);
#pragma unroll
          for (int dt = 0; dt < 4; ++dt) mv[dt] = *(const u32x2*)(Vg + (size_t)(dt * 16 + l16) * MP + mrow0 + 4 * g4); }
        const bf16_t* qbase = QK + (tokb + (size_t)(32 * qd + (wave >> 2)) * 64 + 16 * (wave & 3) + l16) * 2048 + h * 64 + 8 * g4;
        bf16x8 qf0 = *(const bf16x8*)qbase, qf1 = *(const bf16x8*)(qbase + 32);
        __syncthreads();
        for (int u = 0; u < 16; ++u) {
            const int r0 = 2 * (16 * qd + u), rsA = min(max(r0 - 4, 0), 120), rsN = min(max(r0 - 2, 0), 120);
            const bool more = (u < 15) && (rsN != rsA);
            int ts = tid; asm volatile("" : "+v"(ts));
            u32x4 pk0, pk1, pv0, pv1; pk0 = pk1 = pv0 = pv1 = (u32x4){0u, 0u, 0u, 0u};
            const int kq = ts >> 3, kch = ts & 7;
            if (more) { const size_t t0 = tokb + (size_t)(rsA + 9) * 64;
                pk0 = *(const u32x4*)(Kg + (t0 + kq) * 2048 + kch * 8); pk1 = *(const u32x4*)(Kg + (t0 + 64 + kq) * 2048 + kch * 8);
                pv0 = *(const u32x4*)(Vg + (size_t)kq * MP + t0 + kch * 8); pv1 = *(const u32x4*)(Vg + (size_t)kq * MP + t0 + 64 + kch * 8); }
            bf16x8 nq0 = qf0, nq1 = qf1;
            if (u < 15) { const bf16_t* qn = qbase + (size_t)(u + 1) * 128 * 2048; nq0 = *(const bf16x8*)qn; nq1 = *(const bf16x8*)(qn + 32); }
            { const int r = r0 + (wave >> 2), j = wave & 3; int ln = lane; asm volatile("" : "+v"(ln)); na_unit_lds(lds, AO, b, h, r, j, ln, qf0, qf1, mk0, mk1, mv); }
            qf0 = nq0; qf1 = nq1;
            __syncthreads();
            if (more) { const int s0 = rsA % 9, s1 = (rsA + 1) % 9;
                *(LAS u32x4*)(sK + (s0 * 64 + kq) * NA_KP + kch * 8) = pk0; *(LAS u32x4*)(sK + (s1 * 64 + kq) * NA_KP + kch * 8) = pk1;
                *(LAS u32x4*)(sVt + kq * NA_VP + s0 * 64 + kch * 8) = pv0; *(LAS u32x4*)(sVt + kq * NA_VP + s1 * 64 + kch * 8) = pv1; }
            __syncthreads();
        }
    }
    for (int mu = blockIdx.x * NWAVES + wave; mu < 64; mu += gridDim.x * NWAVES) { const int b = mu >> 4, h = mu & 15;
        na_unit<true>(QK, VT, relb + h * 465, metab + h * 16, AO, b, h, 0, 0, lane); }
}

__device__ __forceinline__ void rope_phase(bf16_t* QKV, bf16_t* DST, const float* qn, const float* kn, const f32x2* tab) {
    const int tid = opaque_tid(), lane = tid & 63, wave = tid >> 6, l16 = lane & 15, hq = lane >> 4;
    const int gw = blockIdx.x * NWAVES + wave, NGW = gridDim.x * NWAVES;
    const float C2 = 0.125f * 1.4426950408889634f;
    const float gq0 = qn[l16], gq1 = qn[16 + l16], gq2 = qn[32 + l16], gq3 = qn[48 + l16], gk0 = kn[l16], gk1 = kn[16 + l16], gk2 = kn[32 + l16], gk3 = kn[48 + l16];
    for (int row = gw; row < MR + NMROWS; row += NGW) {
        int pr = 0, pc = 0; if (row < MR) { const int t = row & (SEQL - 1); pr = t >> 6; pc = t & 63; }
        const f32x2 cr = tab[pr * 16 + l16], cc = tab[pc * 16 + l16];
        const bf16_t* src = QKV + (size_t)row * 1536 + hq * 64 + l16;
        unsigned short xin[5][4];
#pragma unroll
        for (int pass = 0; pass < 5; ++pass)
#pragma unroll
            for (int q = 0; q < 4; ++q) xin[pass][q] = src[pass * 256 + 16 * q];
#pragma unroll
        for (int pass = 0; pass < 5; ++pass) {
            const bool isq = pass < 4;
            float x0 = bf2f(xin[pass][0]), x1 = bf2f(xin[pass][1]), x2 = bf2f(xin[pass][2]), x3 = bf2f(xin[pass][3]);
            float ssq = (x0 * x0 + x1 * x1) + (x2 * x2 + x3 * x3);
            ssq += __shfl_xor(ssq, 1); ssq += __shfl_xor(ssq, 2); ssq += __shfl_xor(ssq, 4); ssq += __shfl_xor(ssq, 8);
            const float rs = rsqrtf(ssq * (1.0f / 64.0f) + RMS_EPS);
            x0 *= rs * (isq ? gq0 : gk0); x1 *= rs * (isq ? gq1 : gk1); x2 *= rs * (isq ? gq2 : gk2); x3 *= rs * (isq ? gq3 : gk3);
            float o0 = x0 * cr.x - x1 * cr.y, o1 = x1 * cr.x + x0 * cr.y, o2 = x2 * cc.x - x3 * cc.y, o3 = x3 * cc.x + x2 * cc.y;
            if (isq) { o0 *= C2; o1 *= C2; o2 *= C2; o3 *= C2; }
            bf16_t* q = DST + (size_t)row * 1536 + (pass * 4 + hq) * 64 + l16;
            q[0] = (bf16_t)(pk2(o0, 0.f) & 0xffffu); q[16] = (bf16_t)(pk2(o1, 0.f) & 0xffffu); q[32] = (bf16_t)(pk2(o2, 0.f) & 0xffffu); q[48] = (bf16_t)(pk2(o3, 0.f) & 0xffffu);
        }
    }
}
constexpr int QP = 136, TP = 72;
constexpr int ML_BUF = 60160, ML_OK = 17408, ML_OKT = 34816, ML_OVT = 53248;
constexpr int ML_SS = 2 * ML_BUF, ML_SC = ML_SS + 18432  , ML_SCB = 34 * 272  , ML_SZ = ML_SC + 2 * ML_SCB  , ML_G = ML_SZ + 272, ML_GB = 1552, ML_CH = ML_G + 2 * ML_GB;
__device__ __forceinline__ long ml_row(int b, int dir, int ci, int s) {
    if (dir == 0) { if (ci == 0) return (s < 16) ? (long)MR + b * 16 + s : -1; return (long)b * SEQL + (ci - 1) * 64 + s; }
    if (ci < 128) return (long)b * SEQL + (127 - ci) * 64 + (63 - s);
    return (s < 16) ? (long)MR + b * 16 + 15 - s : -1;
}
__device__ __forceinline__ void mlstm_item(LAS unsigned char* lds, const bf16_t* __restrict__ P, const float* __restrict__ gates, const float* __restrict__ gbias, bf16_t* __restrict__ Hout, float* __restrict__ gsc, int b, int head, int dir, int sl) {
    const int tid = opaque_tid(), lane = tid & 63, wave = tid >> 6, l16 = lane & 15, g = lane >> 4;
    LAS bf16_t* sS = (LAS bf16_t*)(lds + ML_SS) + wave * 16 * TP;
    LAS bf16_t* sC0 = (LAS bf16_t*)(lds + ML_SC); const LAS bf16_t* sZ = (const LAS bf16_t*)(lds + ML_SZ);
    LAS float* sBlast = (LAS float*)(lds + ML_CH); LAS float* sPml = sBlast + 132; LAS float* sMprev = sPml + 132;
    const float kscale = 0.08838834764831845f;
    const float bias_i = gbias[(2 * dir) * 4 + head], bias_f = gbias[(2 * dir + 1) * 4 + head];
    float pgi[17], pgf[17];
#pragma unroll
    for (int k = 0; k < 17; ++k) { const int ci = wave + NWAVES * k; pgi[k] = 0.f; pgf[k] = 0.f;
        if (ci < 129) { const long row = ml_row(b, dir, ci, lane); if (row >= 0) { pgi[k] = gates[row * 16 + (2 * dir) * 4 + head]; pgf[k] = gates[row * 16 + (2 * dir + 1) * 4 + head]; } } }
#pragma unroll
    for (int k = 0; k < 17; ++k) { const int ci = wave + NWAVES * k; if (ci >= 129) break;
        const long row = ml_row(b, dir, ci, lane); const bool valid = row >= 0;
        const float gi = pgi[k], gf = pgf[k];
        const float xf = gf + bias_f;
        const float li = valid ? gi + bias_i : -INFINITY;
        const float lf = valid ? (fminf(xf, 0.f) - __logf(1.f + __expf(-fabsf(xf)))) : 0.f;
        float bc = lf;
#pragma unroll
        for (int o = 1; o < 64; o <<= 1) { const float t = __shfl_up(bc, o); if (lane >= o) bc += t; }
        const float av = li - bc;
        float pm = av;
#pragma unroll
        for (int o = 1; o < 64; o <<= 1) { const float t = __shfl_up(pm, o); if (lane >= o) pm = fmaxf(pm, t); }
        *(f32x4*)(gsc + ((size_t)ci * 64 + lane) * 4) = (f32x4){bc, av, pm, 0.f};
        if (lane == 63) { sBlast[ci] = bc; sPml[ci] = pm; }
    }
    for (int i = tid; i < (2 * ML_SCB + 272) / 2; i += NTHR) sC0[i] = 0;
    for (int i = tid; i < 2 * 16 * TP; i += NTHR) { const int bsel = i / (16 * TP), rem = i - bsel * (16 * TP); const int rw = rem / TP;
        ((LAS bf16_t*)(lds + bsel * ML_BUF + ML_OVT))[(32 + rw) * TP + (rem - rw * TP)] = (rw == 0) ? (bf16_t)0x3F80 : (bf16_t)0; }
    __syncthreads();
    if (tid == 0) { float m = 0.f; for (int ci = 0; ci < 129; ++ci) { sMprev[ci] = m; const float bl = sBlast[ci]; m = fmaxf(bl + m, bl + sPml[ci]); } }
    __syncthreads();
    f32x4 accC[3]; accC[0] = (f32x4){0.f, 0.f, 0.f, 0.f}; accC[1] = accC[0]; accC[2] = accC[0];
    const int ss_ = tid >> 3, d0 = (tid & 7) * 16;
    const int vs_ = tid >> 2, v0 = (tid & 3) * 8;
    u32x4 rq0, rq1, rk0, rk1, rv; f32x4 rgs = (f32x4){0.f, 0.f, 0.f, 0.f}; long rrow = -1;
    const int meta_ci = dir ? 128 : 0, rstride = dir ? -64 : 64;
    const int linQ = dir ? b * SEQL + 127 * 64 + 63 - ss_ : b * SEQL - 64 + ss_, metaQ = (ss_ < 16) ? MR + b * 16 + (dir ? 15 - ss_ : ss_) : -1;
    const int linV = dir ? b * SEQL + 127 * 64 + 63 - vs_ : b * SEQL - 64 + vs_, metaV = (vs_ < 16) ? MR + b * 16 + (dir ? 15 - vs_ : vs_) : -1;
    const int linG = dir ? b * SEQL + 127 * 64 + 63 - tid : b * SEQL - 64 + tid, metaG = (tid < 16) ? MR + b * 16 + (dir ? 15 - tid : tid) : -1;
#define ML_LOAD(ci) do { \
        long row_ = ((ci) == meta_ci) ? metaQ : linQ + rstride * (ci); row_ = (row_ >= 0) ? row_ : (long)b * SEQL;     \
        { const bf16_t* pr_ = P + row_ * 3072 + head * 128 + d0; rq0 = *(const u32x4*)pr_; rq1 = *(const u32x4*)(pr_ + 8); rk0 = *(const u32x4*)(pr_ + 512); rk1 = *(const u32x4*)(pr_ + 520); } \
        if (tid < 256) { long rowv_ = ((ci) == meta_ci) ? metaV : linV + rstride * (ci); rowv_ = (rowv_ >= 0) ? rowv_ : (long)b * SEQL; rv = *(const u32x4*)(P + rowv_ * 3072 + 1024 + head * 256 + sl * 32 + v0); } \
        if (tid < 64) { rrow = ((ci) == meta_ci) ? metaG : linG + rstride * (ci); rrow = (rrow >= 0) ? rrow : (long)(MP - 1);     rgs = *(const f32x4*)(gsc + ((size_t)(ci) * 64 + tid) * 4); } \
    } while (0)
#define ML_STAGE(cs, nb) do { \
        LAS bf16_t* sQ_ = (LAS bf16_t*)(lds + (nb) * ML_BUF); LAS bf16_t* sK_ = (LAS bf16_t*)(lds + (nb) * ML_BUF + ML_OK); LAS bf16_t* sKt_ = (LAS bf16_t*)(lds + (nb) * ML_BUF + ML_OKT); LAS bf16_t* sVt_ = (LAS bf16_t*)(lds + (nb) * ML_BUF + ML_OVT); \
        *(LAS u32x4*)(sQ_ + ss_ * QP + d0) = rq0; *(LAS u32x4*)(sQ_ + ss_ * QP + d0 + 8) = rq1; \
        *(LAS u32x4*)(sK_ + ss_ * QP + d0) = rk0; *(LAS u32x4*)(sK_ + ss_ * QP + d0 + 8) = rk1; \
        { const unsigned kw_[8] = {rk0.x, rk0.y, rk0.z, rk0.w, rk1.x, rk1.y, rk1.z, rk1.w}; \
          const int sc_ = ((((ss_ >> 3) ^ (d0 >> 4)) << 3) | (ss_ & 7)); \
          _Pragma("unroll") for (int e = 0; e < 8; ++e) { sKt_[(d0 + 2 * e) * TP + sc_] = (bf16_t)(kw_[e] & 0xffffu); sKt_[(d0 + 2 * e + 1) * TP + sc_] = (bf16_t)(kw_[e] >> 16); } } \
        if (tid < 256) { const unsigned vw_[4] = {rv.x, rv.y, rv.z, rv.w}; \
          const int vc_ = ((((vs_ >> 3) ^ (v0 >> 3)) << 3) | (vs_ & 7)); \
          _Pragma("unroll") for (int e = 0; e < 4; ++e) { sVt_[(v0 + 2 * e) * TP + vc_] = (bf16_t)(vw_[e] & 0xffffu); sVt_[(v0 + 2 * e + 1) * TP + vc_] = (bf16_t)(vw_[e] >> 16); } } \
        if (tid < 64) { LAS float* G_ = (LAS float*)(lds + ML_G + (nb) * ML_GB); \
            const float bc_ = rgs[0], av_ = rgs[1], pm_ = rgs[2], mp_ = sMprev[(cs)], bl_ = sBlast[(cs)]; \
            const float mn_ = fmaxf(bl_ + mp_, bl_ + sPml[(cs)]), in_ = bc_ + mp_, mt_ = fmaxf(in_, bc_ + pm_); \
            const float pl_ = sPml[(cs)]; G_[tid] = __expf(bc_ - mt_ + pl_); G_[64 + tid] = __expf(av_ - 2.4260151319598084f   - pl_);     G_[128 + tid] = __expf(in_ - mt_); G_[192 + tid] = __expf(-mt_); G_[256 + tid] = __expf(bl_ + av_ - mn_) * kscale; \
            ((LAS int*)G_)[320 + tid] = (int)rrow; if (tid == 0) G_[384] = __expf(bl_ + mp_ - mn_); } \
    } while (0)
    ML_LOAD(0);
    ML_STAGE(0, 0);
    __syncthreads();
    const int tt = wave >> 1, vt = wave & 1; const int ttu = __builtin_amdgcn_readfirstlane(tt);
    for (int ci = 0; ci < 129; ++ci) {
        const int cur = ci & 1;
        const LAS bf16_t* sQ = (const LAS bf16_t*)(lds + cur * ML_BUF); const LAS bf16_t* sK = (const LAS bf16_t*)(lds + cur * ML_BUF + ML_OK);
        const LAS bf16_t* sKt = (const LAS bf16_t*)(lds + cur * ML_BUF + ML_OKT); const LAS bf16_t* sVt = (const LAS bf16_t*)(lds + cur * ML_BUF + ML_OVT);
        const LAS float* G = (const LAS float*)(lds + ML_G + cur * ML_GB);
        const LAS bf16_t* sC = sC0 + cur * (ML_SCB / 2); LAS bf16_t* sCn = sC0 + (cur ^ 1) * (ML_SCB / 2);
        if (ci + 1 < 129) ML_LOAD(ci + 1);
        bf16x8 qf[4];
#pragma unroll
        for (int ks = 0; ks < 4; ++ks) qf[ks] = *(const LAS bf16x8*)(sQ + (tt * 16 + l16) * QP + 32 * ks + 8 * g);
        const float ebt = G[tt * 16 + l16];
#pragma unroll
        for (int st = 0; st < 4; ++st) {
            if (st <= ttu) {
                f32x4 acc = (f32x4){0.f, 0.f, 0.f, 0.f};
#pragma unroll
                for (int ks = 0; ks < 4; ++ks) acc = mfma16(*(const LAS bf16x8*)(sK + (st * 16 + l16) * QP + 32 * ks + 8 * g), qf[ks], acc);
                const f32x4 ea = *(const LAS f32x4*)(G + 64 + st * 16 + 4 * g); const int s0_ = st * 16 + 4 * g, tl = tt * 16 + l16;
                float v[4];
#pragma unroll
                for (int e = 0; e < 4; ++e) v[e] = (s0_ + e <= tl) ? acc[e] * (ebt * ea[e]) : 0.f;
                u32x2 w2; w2.x = pk2(v[0], v[1]); w2.y = pk2(v[2], v[3]);
                *(LAS u32x2*)(sS + l16 * TP + st * 16 + 4 * g) = w2;
            } else {
                *(LAS u32x2*)(sS + l16 * TP + st * 16 + 4 * g) = (u32x2){0u, 0u};
            }
        }
        const int tl_ = tt * 16 + l16;
        const float wi = G[128 + tl_], ei = G[192 + tl_]; const int orow = ((const LAS int*)G)[320 + tl_];
        f32x4 acch = (f32x4){0.f, 0.f, 0.f, 0.f}, accd = acch;
#pragma unroll
        for (int ks = 0; ks < 4; ++ks) { acch = mfma16(*(const LAS bf16x8*)(sC + (vt * 16 + l16) * QP + 32 * ks + 8 * g), qf[ks], acch);
                                          accd = mfma16(*(const LAS bf16x8*)(((l16 == 0) ? sC + 32 * QP : sZ) + 32 * ks + 8 * g), qf[ks], accd); }
#pragma unroll
        for (int e = 0; e < 4; ++e) { acch[e] *= wi; accd[e] *= wi; }
#pragma unroll
        for (int ks = 0; ks < 2; ++ks) { const bf16x8 sf = *(const LAS bf16x8*)(sS + l16 * TP + 32 * ks + 8 * g);
            acch = mfma16(*(const LAS bf16x8*)(sVt + (vt * 16 + l16) * TP + (((4 * ks + g) ^ ((2 * vt + (l16 >> 3)) & 3)) << 3)), sf, acch);
            accd = mfma16(*(const LAS bf16x8*)(sVt + (32 + l16) * TP + 32 * ks + 8 * g), sf, accd); }
        { const float den = __shfl(accd[0], l16);
          const float rd = frcp(fmaxf(fabsf(den), ei));
          u32x2 w2; w2.x = pk2(acch[0] * rd, acch[1] * rd); w2.y = pk2(acch[2] * rd, acch[3] * rd);
          *(u32x2*)(Hout + (size_t)orow * 1024 + head * 256 + sl * 32 + vt * 16 + 4 * g) = w2; }
        {
            const float decay = G[384]; const int dt = wave;
            bf16x8 bfr[2];
#pragma unroll
            for (int ks = 0; ks < 2; ++ks) { const u32x4 kw = *(const LAS u32x4*)(sKt + (dt * 16 + l16) * TP + (((4 * ks + g) ^ dt) << 3));
                const f32x4 w0 = *(const LAS f32x4*)(G + 256 + 32 * ks + 8 * g), w1 = *(const LAS f32x4*)(G + 256 + 32 * ks + 8 * g + 4);
                u32x4 o; o.x = pk2(bflo(kw.x) * w0[0], bfhi(kw.x) * w0[1]); o.y = pk2(bflo(kw.y) * w0[2], bfhi(kw.y) * w0[3]); o.z = pk2(bflo(kw.z) * w1[0], bfhi(kw.z) * w1[1]); o.w = pk2(bflo(kw.w) * w1[2], bfhi(kw.w) * w1[3]);
                bfr[ks] = __builtin_bit_cast(bf16x8, o); }
#pragma unroll
            for (int v2 = 0; v2 < 3; ++v2) {
                accC[v2] = accC[v2] * decay;
#pragma unroll
                for (int ks = 0; ks < 2; ++ks) accC[v2] = mfma16(bfr[ks], *(const LAS bf16x8*)(sVt + (v2 * 16 + l16) * TP + (((4 * ks + g) ^ ((2 * v2 + (l16 >> 3)) & 3)) << 3)), accC[v2]);
                u32x2 w2; w2.x = pk2(accC[v2][0], accC[v2][1]); w2.y = pk2(accC[v2][2], accC[v2][3]);
                if (v2 < 2) *(LAS u32x2*)(sCn + (v2 * 16 + l16) * QP + dt * 16 + 4 * g) = w2;
                else if (l16 == 0) *(LAS u32x2*)(sCn + 32 * QP + dt * 16 + 4 * g) = w2;
            }
        }
        if (ci + 1 < 129) ML_STAGE(ci + 1, cur ^ 1);
        __syncthreads();
    }
#undef ML_LOAD
#undef ML_STAGE
}
__device__ __forceinline__ void mlstm_phase(LAS unsigned char* lds, const bf16_t* P, const float* gates, const float* gbias, bf16_t* HF, bf16_t* HBW, float* gsc_all) {
    for (int it = blockIdx.x; it < 256; it += gridDim.x) {
        const int xq = it & 7, lq = it >> 3; const int sl = lq & 7, ch = xq * 4 + (lq >> 3); const int dir = ch & 1, head = (ch >> 1) & 3, b = ch >> 3;
        mlstm_item(lds, P, gates, gbias, dir ? HBW : HF, gsc_all + (size_t)it * 129 * 64 * 4, b, head, dir, sl);
        __syncthreads();
    }
}
__device__ __forceinline__ void mlstm_combine_phase(const bf16_t* P, const bf16_t* HF, bf16_t* AO, const float* onorm) {
    const int tid = opaque_tid(), lane = tid & 63, wave = tid >> 6;
    const int gw = blockIdx.x * NWAVES + wave, NGW = gridDim.x * NWAVES;
    for (int row = gw; row < MR + NMROWS; row += NGW) {
        u32x2 a[4], c[4], op[4];
#pragma unroll
        for (int hd = 0; hd < 4; ++hd) { const int col = hd * 256 + 4 * lane;
            a[hd] = *(const u32x2*)(HF + (size_t)row * 1024 + col); c[hd] = *(const u32x2*)(AO + (size_t)row * 1024 + col); op[hd] = *(const u32x2*)(P + (size_t)row * 3072 + 2048 + col); }
#pragma unroll
        for (int hd = 0; hd < 4; ++hd) {
            const int col = hd * 256 + 4 * lane;
            float h0 = bflo(a[hd].x) + bflo(c[hd].x), h1 = bfhi(a[hd].x) + bfhi(c[hd].x), h2 = bflo(a[hd].y) + bflo(c[hd].y), h3 = bfhi(a[hd].y) + bfhi(c[hd].y);
            const float ssq = wave_sum((h0 * h0 + h1 * h1) + (h2 * h2 + h3 * h3));
            const float rs = rsqrtf(ssq * (1.0f / 256.0f) + RMS_EPS);
            const f32x4 gn = *(const f32x4*)(onorm + col);
            const float o0 = bflo(op[hd].x), o1 = bfhi(op[hd].x), o2 = bflo(op[hd].y), o3 = bfhi(op[hd].y);
            h0 = h0 * rs * gn[0] * frcp(1.f + __expf(-o0)); h1 = h1 * rs * gn[1] * frcp(1.f + __expf(-o1)); h2 = h2 * rs * gn[2] * frcp(1.f + __expf(-o2)); h3 = h3 * rs * gn[3] * frcp(1.f + __expf(-o3));
            u32x2 w; w.x = pk2(h0, h1); w.y = pk2(h2, h3); *(u32x2*)(AO + (size_t)row * 1024 + col) = w;
        }
    }
}
__device__ __forceinline__ void final_phase(const bf16_t* hin, float* out, const float* ss, const float* gfin, long nperturb) {
    const int tid = opaque_tid(), lane = tid & 63, wave = tid >> 6;
    const int gw = blockIdx.x * NWAVES + wave, NGW = gridDim.x * NWAVES;
    for (int row0 = gw; row0 < MR; row0 += 4 * NGW) {
        u32x2 hw[4][4]; float rs[4];
#pragma unroll
        for (int q = 0; q < 4; ++q) { const int row = min(row0 + q * NGW, MR - 1); rs[q] = rstd_of(ss + (size_t)row * 16);
#pragma unroll
            for (int j = 0; j < 4; ++j) hw[q][j] = *(const u32x2*)(hin + (size_t)row * 1024 + 256 * j + 4 * lane); }
#pragma unroll
        for (int q = 0; q < 4; ++q) { const int row = row0 + q * NGW; if (row < MR) {
#pragma unroll
            for (int j = 0; j < 4; ++j) { const f32x4 gn = *(const f32x4*)(gfin + 256 * j + 4 * lane); f32x4 v;
                v[0] = bflo(hw[q][j].x) * rs[q] * gn[0]; v[1] = bfhi(hw[q][j].x) * rs[q] * gn[1]; v[2] = bflo(hw[q][j].y) * rs[q] * gn[2]; v[3] = bfhi(hw[q][j].y) * rs[q] * gn[3];
                *(f32x4*)(out + (size_t)row * 1024 + 256 * j + 4 * lane) = v; } } }
    }
}

__device__ __forceinline__ void attn_meta_combine_phase(const bf16_t* po, const float* pml, bf16_t* AO) {
    const int gt = blockIdx.x * NTHR + opaque_tid();
    if (gt < 4 * 16 * 16 * 8) {
        const int c8 = gt & 7, r = (gt >> 3) & 15, hd = (gt >> 7) & 15, b = gt >> 11;
        float m[4], l[4], M = -INFINITY;
#pragma unroll
        for (int s = 0; s < 4; ++s) { const size_t pi = (size_t)(((b * 4 + s) * 16 + hd) * 16 + r); m[s] = pml[pi * 2]; l[s] = pml[pi * 2 + 1]; M = fmaxf(M, m[s]); }
        float acc[8] = {0.f, 0.f, 0.f, 0.f, 0.f, 0.f, 0.f, 0.f}, wsum = 0.f;
#pragma unroll
        for (int s = 0; s < 4; ++s) { const size_t pi = (size_t)(((b * 4 + s) * 16 + hd) * 16 + r); const float w = l[s] * exp2f(m[s] - M); wsum += w;
            const u32x4 v = *(const u32x4*)(po + pi * 64 + c8 * 8);
            acc[0] += w * bflo(v.x); acc[1] += w * bfhi(v.x); acc[2] += w * bflo(v.y); acc[3] += w * bfhi(v.y); acc[4] += w * bflo(v.z); acc[5] += w * bfhi(v.z); acc[6] += w * bflo(v.w); acc[7] += w * bfhi(v.w); }
        const float inv = 1.0f / wsum;
        u32x4 o; o.x = pk2(acc[0] * inv, acc[1] * inv); o.y = pk2(acc[2] * inv, acc[3] * inv); o.z = pk2(acc[4] * inv, acc[5] * inv); o.w = pk2(acc[6] * inv, acc[7] * inv);
        *(u32x4*)(AO + (size_t)(MR + b * 16 + r) * 1024 + hd * 64 + c8 * 8) = o;
    }
}

constexpr int N_PHASES = 30;
#ifndef REP_NA
#define REP_NA 1
#endif
#ifndef REP_ATTN
#define REP_ATTN 1
#endif
#ifndef REP_ML
#define REP_ML 1
#endif
#ifndef REP_G0
#define REP_G0 1
#endif
#ifndef REP_G2
#define REP_G2 1
#endif
#ifndef REP_PRO
#define REP_PRO 1
#endif
#ifndef REP_SYNC
#define REP_SYNC 1
#endif
#ifndef REP_DRY
#define REP_DRY 1
#endif
#ifndef EN_PRO
#define EN_PRO 1
#endif
#ifndef EN_GEMM0
#define EN_GEMM0 1
#endif
#ifndef EN_GEMM1
#define EN_GEMM1 1
#endif
#ifndef EN_GEMM2
#define EN_GEMM2 1
#endif
#ifndef EN_NA
#define EN_NA 1
#endif
#ifndef EN_ATTN
#define EN_ATTN 1
#endif
#ifndef EN_ML
#define EN_ML 1
#endif
__device__ __forceinline__ bool phase_active(int ph) {
    if (ph == 0 || ph == 29) return true;
    const int layer = (ph - 1) / 7, s = (ph - 1) % 7;
    if (s == 1) return layer == 1;
    if (s == 3) return layer == 2 || layer == 1;
    return true;
}
__global__ void __launch_bounds__(NTHR, 2) fwd_kernel(Args args) {
    extern __shared__ __attribute__((aligned(16))) unsigned char lds_raw[];
    LAS unsigned char* lds = (LAS unsigned char*)lds_raw;
    cg::grid_group grid = cg::this_grid();
    unsigned char* ws = args.ws;
    bf16_t* HB = (bf16_t*)(ws + OFF_HB); bf16_t* AO = (bf16_t*)(ws + OFF_AO); bf16_t* QKV = (bf16_t*)(ws + OFF_QKV); bf16_t* VT = (bf16_t*)(ws + OFF_VT);
    float* SS = (float*)(ws + OFF_SS); float* GATES = (float*)(ws + OFF_GATES);
    if (threadIdx.x < 32) ((LAS unsigned*)(lds + MISC_OFF))[threadIdx.x] = 0u;
    __syncthreads();
    XcdBarrier bar = xcd_barrier_post((unsigned*)(ws + OFF_BAR), (volatile LAS unsigned*)(lds + MISC_OFF) + 8);
    bool did = false; int nsync = 0;
    for (int ph = args.ph_lo; ph < args.ph_hi; ++ph) {
        if (!phase_active(ph)) continue;
        if (did) for (int rep_ = 0; rep_ < REP_SYNC; ++rep_) { if (args.ph_lo < 0) grid.sync();
            xcd_barrier(bar); ++nsync; }
        did = true;
        if (ph == 0) { if (EN_PRO) for (int rep_ = 0; rep_ < REP_PRO; ++rep_) { prologue_phase(args, lds); __syncthreads(); } continue; }
        if (PROBE_ON && blockIdx.x == 0 && threadIdx.x == 0) ((unsigned long long*)(ws + OFF_TS))[ph] = __builtin_amdgcn_s_memrealtime();
        if (ph == 29) { long np = 0;
            if (PROBE_ON) { const unsigned long long* ts = (const unsigned long long*)(ws + OFF_TS); long ta = 0, tb = 0;
                for (int p = 0; p < 29; ++p) { if (!phase_active(p)) continue; int q = p + 1; while (!phase_active(q)) ++q; const long d = (long)(ts[q] - ts[p]);
                    const int sp = (p == 0) ? 7 : (p - 1) % 7; if ((PROBE_A >> sp) & 1) ta += d; if ((PROBE_B >> sp) & 1) tb += d; }
                long a = ta / 2000, b = tb / 2000; if (a > 99) a = 99; if (b > 99) b = 99; np = (a * 20000 + b * 200) & ~3L; }
            final_phase(HB, args.out, SS + (size_t)8 * MP * 16, args.in[4], np); continue; }
        const int layer = (ph - 1) / 7, s = (ph - 1) % 7;
        const int kind = (layer == 1) ? 1 : (layer == 2) ? 2 : 0, ja = (layer == 3) ? 1 : 0;
        const float* ss_mix = SS + (size_t)(2 * layer) * MP * 16; float* ss_ffn = SS + (size_t)(2 * layer + 1) * MP * 16; float* ss_next = SS + (size_t)(2 * layer + 2) * MP * 16;
        if (s == 0) { if (EN_GEMM0) for (int rep_ = 0; rep_ < REP_G0; ++rep_) {
            const bf16_t* W = (kind == 0) ? (const bf16_t*)(ws + OFF_W_AQKV + (size_t)ja * 6 * MiB) : (kind == 1) ? (const bf16_t*)(ws + OFF_W_BQKV) : (const bf16_t*)(ws + OFF_W_CIN);
            const int N = (kind == 0) ? 2048 : (kind == 1) ? 1536 : 3072;
            const int ldc = (kind == 0) ? 2048 : (kind == 1) ? 1536 : 3072;
            { const StripEpi SE{SE_SCALE, QKV, ldc, ss_mix, nullptr, nullptr, nullptr}; strip_phase(lds, HB + (size_t)MR * 1024, W, 1024, N / 64, false, SE); }
            if (kind == 2) gates_phase(HB, W + (size_t)3072 * 1024, ss_mix, GATES);
            pg8::Gemm gm{HB, W, MR, N, 1024}; pg8::StaticOrder S; S.init(MR, N, gridDim.x, blockIdx.x);
            EpiScaleBf16 E{QKV, ldc, ss_mix};
            pg8::gemm_phase<EpiScaleBf16, pg8::StaticOrder, PG_ALIGN, PG_SP2>(lds, gm, S, E);
            if (kind == 0) {
                { const StripEpi SE{SE_SCALECOL, VT, MP, ss_mix, nullptr, nullptr, nullptr}; strip_phase(lds, W + (size_t)2048 * 1024, HB + (size_t)MR * 1024, 1024, 16, true, SE); }
                pg8::Gemm g2{W + (size_t)2048 * 1024, HB, 1024, MR, 1024}; pg8::StaticOrder S2; S2.init(1024, MR, gridDim.x, blockIdx.x);
                EpiScaleColBf16 E2{VT, MP, ss_mix};
                pg8::gemm_phase<EpiScaleColBf16, pg8::StaticOrder, PG_ALIGN, PG_SP2>(lds, g2, S2, E2);
            } }
        } else if (s == 1) {
            rope_phase(QKV, QKV, args.in[10], args.in[11], (const f32x2*)(ws + OFF_ROPE));
        } else if (s == 2) {
            if (kind == 0) { if (EN_NA) for (int rep_ = 0; rep_ < REP_NA; ++rep_) na_phase(lds, QKV, VT, args.in[6] + (size_t)ja * 16 * 465, args.in[7] + (size_t)ja * 256, AO); }
            else if (kind == 1) { if (EN_ATTN) for (int rep_ = 0; rep_ < REP_ATTN; ++rep_) {
                const int xcd = blockIdx.x & 7, l = blockIdx.x >> 3; const bool g256 = (gridDim.x == 256);
                const int nun = g256 ? 8 : (2048 - (int)blockIdx.x + (int)gridDim.x - 1) / (int)gridDim.x;
                for (int i = 0; i < nun; ++i) {
                    int b_, h_, qb_;
                    if (g256) { const int pair = 2 * xcd + (i >> 2); b_ = pair >> 2; h_ = (pair & 3) * 4 + (i & 3); qb_ = l; }
                    else { const int u = blockIdx.x + i * gridDim.x; b_ = u >> 9; h_ = (u >> 5) & 15; qb_ = u & 31; }
                    attn_body::attn_unit<8, false>(b_, h_, qb_, 0, 130, (const attn_body::bf16*)QKV, (attn_body::bf16*)AO, nullptr, nullptr, (char*)lds_raw);
                }
                for (int mu = blockIdx.x; mu < 64; mu += gridDim.x)
                    attn_body::attn_unit<8, true>(mu >> 4, ((mu >> 2) & 3) * 4, 32, 32 * (mu & 3), ((mu & 3) == 3) ? 34 : 32, (const attn_body::bf16*)QKV, (attn_body::bf16*)AO, (attn_body::bf16*)(ws + OFF_HX), (float*)(ws + OFF_HX + 524288), (char*)lds_raw);
                if (g256) { if (blockIdx.x >= 64) { __syncthreads(); weight_items<1>(args, lds, (int)blockIdx.x - 64, 192); } }
                else { __syncthreads(); weight_items<1>(args, lds, (int)blockIdx.x, (int)gridDim.x); }
                }
            } else { if (EN_ML) for (int rep_ = 0; rep_ < REP_ML; ++rep_) mlstm_phase(lds, QKV, GATES, args.in[14], (bf16_t*)args.out  , AO, (float*)(ws + OFF_GSC)); }
        } else if (s == 3) {
            if (layer == 1) attn_meta_combine_phase((const bf16_t*)(ws + OFF_HX), (const float*)(ws + OFF_HX + 524288), AO);
            else mlstm_combine_phase(QKV, (const bf16_t*)args.out, AO, args.in[15]);
        } else if (s == 4 || s == 6) { if (EN_GEMM1) {
            const bf16_t* W = (s == 6) ? (const bf16_t*)(ws + OFF_W2 + (size_t)layer * 11 * MiB / 2)
                            : (kind == 0) ? (const bf16_t*)(ws + OFF_W_AO + (size_t)ja * 2 * MiB) : (kind == 1) ? (const bf16_t*)(ws + OFF_W_BO) : (const bf16_t*)(ws + OFF_W_CO);
            const int Kd = (s == 6) ? FFH : 1024; const bf16_t* Ain = (s == 6) ? QKV : AO; float* ssw = (s == 6) ? ss_next : ss_ffn;
            { const StripEpi SE{SE_RESID, nullptr, 0, nullptr, nullptr, HB, ssw}; strip_phase(lds, Ain + (size_t)MR * Kd, W, Kd, 16, false, SE); }
            pg8::Gemm gm{Ain, W, MR, 1024, Kd}; pg8::StaticOrder S; S.init(MR, 1024, gridDim.x, blockIdx.x);
            EpiResid E{HB, ssw};
            pg8::gemm_phase<EpiResid, pg8::StaticOrder, PG_ALIGN, PG_SP2>(lds, gm, S, E); }
        } else if (EN_GEMM2) for (int rep_ = 0; rep_ < REP_G2; ++rep_) {
            const bf16_t* W13 = (const bf16_t*)(ws + OFF_W13 + (size_t)layer * 11 * MiB);
            { const StripEpi SE{SE_SWIGLU, QKV, 0, ss_ffn, nullptr, nullptr, nullptr}; strip_phase(lds, HB + (size_t)MR * 1024, W13, 1024, 88, false, SE); }
            pg8::Gemm gm{HB, W13, MR, 2 * FFH, 1024}; pg8::StaticOrder S; S.init(MR, 2 * FFH, gridDim.x, blockIdx.x);
            EpiSwiglu E{QKV, ss_ffn};
            pg8::gemm_phase<EpiSwiglu, pg8::StaticOrder, PG_ALIGN, PG_SP2>(lds, gm, S, E);
        }
    }
}

#ifndef ONE_LAUNCH
#define ONE_LAUNCH 1
#endif
extern "C" void kernel_launch(void* const* d_in, const int* in_sizes, int n_in, void* d_out, int out_size, void* d_ws, size_t ws_size, hipStream_t stream) {
    static int grid = 0;
    if (grid == 0) {
        if (n_in != 20 || out_size != MR * 1024 || ws_size < WS_END) { fprintf(stderr, "kernel_launch: unexpected shapes (n_in %d out %d ws %zu)\n", n_in, out_size, ws_size); grid = -1; return; }
        int dev = 0, cus = 0, per_cu = 0;
        hipGetDevice(&dev); hipDeviceGetAttribute(&cus, hipDeviceAttributeMultiprocessorCount, dev);
        if (hipFuncSetAttribute((const void*)fwd_kernel, hipFuncAttributeMaxDynamicSharedMemorySize, LDS_BYTES) != hipSuccess) { fprintf(stderr, "kernel_launch: hipFuncSetAttribute failed\n"); grid = -1; return; }
        if (hipOccupancyMaxActiveBlocksPerMultiprocessor(&per_cu, (const void*)fwd_kernel, NTHR, LDS_BYTES) != hipSuccess || per_cu < 1) { fprintf(stderr, "kernel_launch: occupancy query says %d\n", per_cu); per_cu = 1; }
        (void)hipGetLastError();
        grid = cus;
    }
    if (grid < 0) return;
    if (hipMemsetAsync((char*)d_ws + OFF_BAR, 0, BAR_BYTES, stream) != hipSuccess) { fprintf(stderr, "kernel_launch: memset of the barrier words failed\n"); return; }
    Args a{};
    for (int i = 0; i < 20; ++i) a.in[i] = (const float*)d_in[i];
    a.out = (float*)d_out; a.ws = (unsigned char*)d_ws;
#if ONE_LAUNCH
    a.ph_lo = 0; a.ph_hi = N_PHASES;
    void* kargs[] = {&a};
    hipError_t e = hipLaunchCooperativeKernel((const void*)fwd_kernel, dim3(grid), dim3(NTHR), kargs, LDS_BYTES, stream);
    if (e != hipSuccess) fprintf(stderr, "kernel_launch: cooperative launch failed: %s (grid %d)\n", hipGetErrorString(e), grid);
#else
    for (int ph = 0; ph < N_PHASES; ++ph) {
        a.ph_lo = ph; a.ph_hi = ph + 1;
        hipLaunchKernelGGL(fwd_kernel, dim3(grid), dim3(NTHR), LDS_BYTES, stream, a);
    }
#endif
}
```

```cpp
#include <hip/hip_runtime.h>
#include <hip/hip_cooperative_groups.h>
#include <hip/hip_bf16.h>
#include <cstdio>
#include <cstdint>
#include <cmath>
namespace cg = cooperative_groups;
namespace pg8 {
#define PG8_LAS __attribute__((address_space(3)))
typedef unsigned short bf16_t;
typedef short bf16x8 __attribute__((ext_vector_type(8)));
typedef float f32x4 __attribute__((ext_vector_type(4)));
typedef unsigned u32x4 __attribute__((ext_vector_type(4)));
constexpr int BM = 256, BK = 64, HALF = 128, HTB = HALF * BK * 2  , STAGE_BYTES = 8 * HTB, NXCD = 8, WGM = 4;

__host__ __device__ __forceinline__ int lds_byte(int r, int c) { const int st = (r >> 4) * 2 + (c >> 5), rr = r & 15, cc = c & 31, ob = rr * 64 + cc * 2; return st * 1024 + (ob ^ (((ob >> 9) & 1) << 5)); }
__host__ __device__ __forceinline__ void stage_rc(int b, int& R, int& C) { const int st = b / 1024, sb = b % 1024, swz = sb ^ (((sb >> 9) & 1) << 5); R = (st >> 1) * 16 + swz / 64; C = (st & 1) * 32 + (swz % 64) / 2; }
__host__ __device__ __forceinline__ int perm32(int rho) { const int n = rho >> 4, i = rho & 15; return 8 * (i >> 2) + 4 * n + (i & 3); }

struct Unit { int pm, pn; };
struct Gemm { const bf16_t* A; const bf16_t* Bt; int M, N, K; };

struct StaticOrder {
    int nM, nN, nwg, G, c;
    __host__ __device__ void init(int M, int N, int G_, int c_) { nM = M / BM; nN = N / BM; nwg = nM * nN; G = G_; c = c_; }
    __host__ __device__ bool next(int i, Unit& u) const {
        const long L = (long)i * G + c; if (L >= nwg) return false;
        int wgid = (int)L; { const int q = nwg / NXCD, r = nwg % NXCD, xcd = wgid % NXCD, off = wgid / NXCD; wgid = (xcd < r ? xcd * (q + 1) : r * (q + 1) + (xcd - r) * q) + off; }
        const int nig = WGM * nN, gid = wgid / nig, fm = gid * WGM, gsz = (nM - fm) < WGM ? (nM - fm) : WGM;
        u.pm = fm + ((wgid % nig) % gsz); u.pn = (wgid % nig) / gsz; return true;
    }
    __device__ __forceinline__ void a_ready(const Unit&) const {}
    __device__ __forceinline__ void done(const Unit&) const {}
};

__device__ __forceinline__ unsigned cvt_pk_bf16(float lo, float hi) { unsigned r; asm volatile("v_cvt_pk_bf16_f32 %0, %1, %2" : "=v"(r) : "v"(lo), "v"(hi)); return r; }
template <class Epi, class Sched, bool ALIGN_EPI = false, bool SP2 = false>
__device__ __forceinline__ void gemm_phase(PG8_LAS unsigned char* lds, const Gemm g, const Sched& S, const Epi& E) {
    int tid_ = threadIdx.x; asm volatile("" : "+v"(tid_));
    const int tid = tid_, wid = __builtin_amdgcn_readfirstlane(tid >> 6), lane = tid & 63, wr = wid >> 2, wc = wid & 3, fr = lane & 15, fq = lane >> 4;
    const int K = g.K, nt = K / BK;
    unsigned voffA[2], voffB[2];
#pragma unroll
    for (int i = 0; i < 2; ++i) { int R, C; stage_rc(tid * 16 + i * 8192, R, C); const int Rb = Epi::PERM ? ((R & ~31) + perm32(R & 31)) : R;
        voffA[i] = (unsigned)(R * K + C) * 2u; voffB[i] = (unsigned)(Rb * K + C) * 2u; }
    const size_t kstep = (size_t)(BK * 2);
    const size_t hstep = (size_t)HALF * K * 2;
    const size_t tstep = 2 * hstep;
    const unsigned ldsw = (unsigned)wid * 1024u;
    const int aoff = lds_byte(wr * 64 + fr, fq * 8), boff = lds_byte(wc * 32 + fr, fq * 8);
#define PG8_SA(b, h) (((b) * 2 + (h)) * HTB)
#define PG8_SB(b, h) ((4 + (b) * 2 + (h)) * HTB)
#define PG8_STAGE(bufoff, gbase, voff) do { _Pragma("unroll") for (int _i = 0; _i < 2; ++_i) \
        __builtin_amdgcn_global_load_lds((const unsigned*)((const char*)(gbase) + (voff)[_i]), (PG8_LAS unsigned*)(lds + (bufoff) + ldsw + _i * 8192), 16, 0, 0); } while (0)
#define PG8_LDA(dst, b, h) do { _Pragma("unroll") for (int m = 0; m < 4; ++m) _Pragma("unroll") for (int k = 0; k < 2; ++k) dst[m][k] = *(const PG8_LAS bf16x8*)(lds + PG8_SA(b, h) + aoff + m * 2048 + k * 1024); } while (0)
#define PG8_LDB(dst, b, h) do { _Pragma("unroll") for (int n = 0; n < 2; ++n) _Pragma("unroll") for (int k = 0; k < 2; ++k) dst[n][k] = *(const PG8_LAS bf16x8*)(lds + PG8_SB(b, h) + boff + n * 2048 + k * 1024); } while (0)
#define PG8_MMA(ai, bj, At, Bt) do { __builtin_amdgcn_s_setprio(1); _Pragma("unroll") for (int m = 0; m < 4; ++m) _Pragma("unroll") for (int n = 0; n < 2; ++n) _Pragma("unroll") for (int k = 0; k < 2; ++k) \
        acc[ai][bj][m][n] = __builtin_amdgcn_mfma_f32_16x16x32_bf16(Bt[n][k], At[m][k], acc[ai][bj][m][n], 0, 0, 0); __builtin_amdgcn_s_setprio(0); } while (0)
#define PG8_WAIT_V(n) asm volatile("s_waitcnt vmcnt(" #n ")" ::: "memory")
#define PG8_WAIT_L(n) asm volatile("s_waitcnt lgkmcnt(" #n ")" ::: "memory")
#define PG8_BAR __builtin_amdgcn_s_barrier()
#define PG8_SCHED __builtin_amdgcn_sched_barrier(0)
    Unit cur, nxt; int ui = 0;
    if (!S.next(0, cur)) return;
    f32x4 acc[2][2][4][2];
#pragma unroll
    for (int a = 0; a < 2; ++a)
#pragma unroll
        for (int b = 0; b < 2; ++b)
#pragma unroll
            for (int m = 0; m < 4; ++m)
#pragma unroll
                for (int n = 0; n < 2; ++n) acc[a][b][m][n] = (f32x4){0.f, 0.f, 0.f, 0.f};
    bf16x8 At[4][2], B0[2][2], B1[2][2];
    const char* cA = (const char*)g.A + (size_t)cur.pm * tstep; const char* cB = (const char*)g.Bt + (size_t)cur.pn * tstep;
    S.a_ready(cur);
    if constexpr (SP2) {
        PG8_STAGE(PG8_SB(0, 0), cB, voffB); PG8_STAGE(PG8_SB(0, 1), cB + hstep, voffB); PG8_STAGE(PG8_SA(0, 0), cA, voffA); PG8_STAGE(PG8_SA(0, 1), cA + hstep, voffA);
        if (wr == 1) PG8_BAR;
        PG8_WAIT_V(2); PG8_BAR;
        PG8_STAGE(PG8_SB(1, 0), cB + kstep, voffB); PG8_STAGE(PG8_SA(1, 0), cA + kstep, voffA); PG8_STAGE(PG8_SB(1, 1), cB + hstep + kstep, voffB);
        PG8_WAIT_V(6); PG8_BAR;
    } else {
        PG8_STAGE(PG8_SB(0, 0), cB, voffB); PG8_STAGE(PG8_SA(0, 0), cA, voffA); PG8_STAGE(PG8_SB(0, 1), cB + hstep, voffB); PG8_STAGE(PG8_SA(0, 1), cA + hstep, voffA);
        if (wr == 1) PG8_BAR;
        PG8_WAIT_V(4); PG8_BAR;
        PG8_STAGE(PG8_SB(1, 0), cB + kstep, voffB); PG8_STAGE(PG8_SA(1, 0), cA + kstep, voffA); PG8_STAGE(PG8_SB(1, 1), cB + hstep + kstep, voffB);
        PG8_WAIT_V(6); PG8_BAR;
    }
    for (;;) {
        const bool has_next = S.next(ui + 1, nxt);
        const char* nA = has_next ? (const char*)g.A + (size_t)nxt.pm * tstep : cA; const char* nB = has_next ? (const char*)g.Bt + (size_t)nxt.pn * tstep : cB;
        for (int t = 0; t < nt; t += 2) {
            const bool last = (t == nt - 2);
            const char* a1 = cA + (size_t)(t + 1) * kstep;
            const char* a2 = last ? nA : cA + (size_t)(t + 2) * kstep; const char* b2 = last ? nB : cB + (size_t)(t + 2) * kstep;
            const char* a3 = a2 + kstep; const char* b3 = b2 + kstep;
            if (last && has_next) S.a_ready(nxt);
            if constexpr (SP2) {
            PG8_LDB(B0, 0, 0); PG8_LDB(B1, 0, 1); PG8_SCHED; PG8_LDA(At, 0, 0); PG8_STAGE(PG8_SA(1, 1), a1 + hstep, voffA);
            PG8_WAIT_V(8); PG8_WAIT_L(0); PG8_BAR; PG8_MMA(0, 0, At, B0); PG8_MMA(0, 1, At, B1); PG8_BAR; PG8_SCHED;
            PG8_LDA(At, 0, 1); PG8_STAGE(PG8_SB(0, 0), b2, voffB); PG8_STAGE(PG8_SB(0, 1), b2 + hstep, voffB); PG8_STAGE(PG8_SA(0, 0), a2, voffA);
            PG8_WAIT_V(8); PG8_WAIT_L(0); PG8_BAR; PG8_MMA(1, 0, At, B0); PG8_MMA(1, 1, At, B1); PG8_BAR; PG8_SCHED;
            PG8_LDB(B0, 1, 0); PG8_LDB(B1, 1, 1); PG8_SCHED; PG8_LDA(At, 1, 0); PG8_STAGE(PG8_SA(0, 1), a2 + hstep, voffA);
            PG8_WAIT_V(8); PG8_WAIT_L(0); PG8_BAR; PG8_MMA(0, 0, At, B0); PG8_MMA(0, 1, At, B1); PG8_BAR; PG8_SCHED;
            PG8_LDA(At, 1, 1); PG8_STAGE(PG8_SB(1, 0), b3, voffB); PG8_STAGE(PG8_SB(1, 1), b3 + hstep, voffB); PG8_STAGE(PG8_SA(1, 0), a3, voffA);
            PG8_WAIT_V(8); PG8_WAIT_L(0); PG8_BAR; PG8_MMA(1, 0, At, B0); PG8_MMA(1, 1, At, B1); PG8_BAR; PG8_SCHED;
            } else {
            PG8_LDB(B0, 0, 0); PG8_SCHED; PG8_LDA(At, 0, 0); PG8_STAGE(PG8_SA(1, 1), a1 + hstep, voffA);
            PG8_WAIT_L(8); PG8_BAR; PG8_WAIT_L(0); PG8_MMA(0, 0, At, B0); PG8_BAR; PG8_SCHED;
            PG8_LDB(B1, 0, 1); PG8_STAGE(PG8_SB(0, 0), b2, voffB);
            PG8_BAR; PG8_WAIT_L(0); PG8_MMA(0, 1, At, B1); PG8_BAR;
            PG8_LDA(At, 0, 1); PG8_STAGE(PG8_SA(0, 0), a2, voffA);
            PG8_BAR; PG8_WAIT_L(0); PG8_MMA(1, 0, At, B0); PG8_BAR; PG8_SCHED;
            PG8_STAGE(PG8_SB(0, 1), b2 + hstep, voffB);
            PG8_WAIT_V(6); PG8_BAR; PG8_MMA(1, 1, At, B1); PG8_BAR;
            PG8_LDB(B0, 1, 0); PG8_SCHED; PG8_LDA(At, 1, 0); PG8_STAGE(PG8_SA(0, 1), a2 + hstep, voffA);
            PG8_WAIT_L(8); PG8_BAR; PG8_WAIT_L(0); PG8_MMA(0, 0, At, B0); PG8_BAR; PG8_SCHED;
            PG8_LDB(B1, 1, 1); PG8_STAGE(PG8_SB(1, 0), b3, voffB);
            PG8_BAR; PG8_WAIT_L(0); PG8_MMA(0, 1, At, B1); PG8_BAR;
            PG8_LDA(At, 1, 1); PG8_STAGE(PG8_SA(1, 0), a3, voffA);
            PG8_BAR; PG8_WAIT_L(0); PG8_MMA(1, 0, At, B0); PG8_BAR; PG8_SCHED;
            PG8_STAGE(PG8_SB(1, 1), b3 + hstep, voffB);
            PG8_WAIT_V(6); PG8_BAR; PG8_MMA(1, 1, At, B1); PG8_BAR;
            }
        }
        if constexpr (ALIGN_EPI) { if (wr == 0) PG8_BAR; }
        if constexpr (!Epi::AFTER_DRAIN) { E(acc, cur, wr, wc, fr, fq); S.done(cur); }
        if (!has_next) break;
#pragma unroll
        for (int a = 0; a < 2; ++a)
#pragma unroll
            for (int b = 0; b < 2; ++b)
#pragma unroll
                for (int m = 0; m < 4; ++m)
#pragma unroll
                    for (int n = 0; n < 2; ++n) acc[a][b][m][n] = (f32x4){0.f, 0.f, 0.f, 0.f};
        cur = nxt; cA = nA; cB = nB; ++ui;
        if constexpr (ALIGN_EPI) { if (wr == 1) PG8_BAR; }
    }
    PG8_WAIT_V(0);
    if constexpr (!ALIGN_EPI) { if (wr == 0) PG8_BAR; }
    PG8_BAR;
    if constexpr (Epi::AFTER_DRAIN) { E.fused(acc, cur, wr, wc, fr, fq, lds, wid, lane); S.done(cur); }
#undef PG8_SA
#undef PG8_SB
#undef PG8_STAGE
#undef PG8_LDA
#undef PG8_LDB
#undef PG8_MMA
#undef PG8_WAIT_V
#undef PG8_WAIT_L
#undef PG8_BAR
#undef PG8_SCHED
}
}
namespace attn_body {
using bf16=__hip_bfloat16;
using bf16x8=__attribute__((ext_vector_type(8)))short;
using s16x4=__attribute__((ext_vector_type(4)))short;
using f32x16=__attribute__((ext_vector_type(16)))float;
using u32x4=__attribute__((ext_vector_type(4)))unsigned;
constexpr int D=64,PQ=1536,PO=1024,SEQR=8192,MROW0=32768;
constexpr int NW=8,QBLK=32,QB=QBLK*NW,KVBLK=64;
__device__ __forceinline__ int crow(int r,int hi){return (r&3)+8*(r>>2)+4*hi;}
#define SBAR() __builtin_amdgcn_sched_barrier(0)
__device__ __forceinline__ void cmask(f32x16&p0,f32x16&p1,int jb,int hi){
  const float NEG=-INFINITY;
  #pragma unroll
  for(int r=0;r<16;++r){int kv=crow(r,hi); if(jb==1||kv>=16)p0[r]=NEG; p1[r]=NEG;}
}

constexpr int NSLOT=3, SLOTB=8192;
constexpr int LDS_K=0, LDS_V=NSLOT*SLOTB, LDS_WS=2*NSLOT*SLOTB, LDS_OST=LDS_WS+NW*64*4, LDS_BYTES=LDS_OST+NW*4096;
constexpr float C2=0.125f*1.4426950408889634f;
__device__ __forceinline__ void glds16(const void*gsrc,unsigned lds_dst){unsigned keep;
  asm volatile("s_mov_b32 %0, m0\n\ts_mov_b32 m0, %2\n\ts_nop 0\n\tglobal_load_lds_dwordx4 %1, off\n\ts_mov_b32 m0, %0":"=&s"(keep):"v"(gsrc),"s"(lds_dst):"memory");}
__device__ __forceinline__ float max3f(float a,float b,float c){float r;asm("v_max3_f32 %0, %1, %2, %3":"=v"(r):"v"(a),"v"(b),"v"(c));return r;}
__device__ __forceinline__ float max2f(float a,float b){float r;asm("v_max_f32_e32 %0, %1, %2":"=v"(r):"v"(a),"v"(b));return r;}
__device__ __forceinline__ float fadd_s(float a,float b){float r;asm("v_add_f32_e32 %0, %1, %2":"=v"(r):"v"(a),"v"(b));return r;}
__device__ __forceinline__ float fsub_s(float a,float b){float r;asm("v_sub_f32_e32 %0, %1, %2":"=v"(r):"v"(a),"v"(b));return r;}
typedef float f32x2_t __attribute__((ext_vector_type(2))); typedef __bf16 bf16x2_t __attribute__((ext_vector_type(2)));
__device__ __forceinline__ unsigned cvtpk_s(float lo,float hi){f32x2_t v={lo,hi};bf16x2_t b=__builtin_convertvector(v,bf16x2_t);return __builtin_bit_cast(unsigned,b);}
#define WAIT_BAR(N) asm volatile("s_waitcnt vmcnt(" #N ") lgkmcnt(0)\n\ts_barrier":::"memory")

__device__ __forceinline__ void qkt(f32x16&p0,f32x16&p1,const char*Kslot,const bf16x8*qr,const f32x16&negm,int r32,int hi){
  const char*kb=Kslot+hi*1024+r32*16;
  #pragma unroll
  for(int d0=0;d0<4;++d0){
    const bf16x8 b0=*reinterpret_cast<const bf16x8*>(kb+d0*2048);
    const bf16x8 b1=*reinterpret_cast<const bf16x8*>(kb+d0*2048+512);
    if(d0==0){p0=__builtin_amdgcn_mfma_f32_32x32x16_bf16(b0,qr[0],negm,0,0,0);p1=__builtin_amdgcn_mfma_f32_32x32x16_bf16(b1,qr[0],negm,0,0,0);}
    else{p0=__builtin_amdgcn_mfma_f32_32x32x16_bf16(b0,qr[d0],p0,0,0,0);p1=__builtin_amdgcn_mfma_f32_32x32x16_bf16(b1,qr[d0],p1,0,0,0);}}
}
typedef __attribute__((address_space(3))) const char* lds_cptr;
typedef short v4i16_t __attribute__((ext_vector_type(4)));
__device__ __forceinline__ void kload8(bf16x8*kf,lds_cptr kp){
  kf[0]=*(const __attribute__((address_space(3))) bf16x8*)(kp);      kf[1]=*(const __attribute__((address_space(3))) bf16x8*)(kp+512);
  kf[2]=*(const __attribute__((address_space(3))) bf16x8*)(kp+2048); kf[3]=*(const __attribute__((address_space(3))) bf16x8*)(kp+2560);
  kf[4]=*(const __attribute__((address_space(3))) bf16x8*)(kp+4096); kf[5]=*(const __attribute__((address_space(3))) bf16x8*)(kp+4608);
  kf[6]=*(const __attribute__((address_space(3))) bf16x8*)(kp+6144); kf[7]=*(const __attribute__((address_space(3))) bf16x8*)(kp+6656);
}
__device__ __forceinline__ void kload2(bf16x8*kf,lds_cptr kp,int j){ kf[2*j]=*(const __attribute__((address_space(3))) bf16x8*)(kp+j*2048); kf[2*j+1]=*(const __attribute__((address_space(3))) bf16x8*)(kp+j*2048+512); }
__device__ __forceinline__ s16x4 vtr(lds_cptr p){ return __builtin_bit_cast(s16x4,__builtin_amdgcn_ds_read_tr16_b64_v4i16((__attribute__((address_space(3))) v4i16_t*)p)); }
__device__ __forceinline__ float rowmax(const f32x16&p0,const f32x16&p1){
  float a=max3f(p0[0],p0[1],p1[0]),b=max3f(p0[2],p0[3],p1[1]);a=max3f(a,p1[2],p1[3]);
  #pragma unroll
  for(int r=4;r<16;r+=4){a=max3f(a,p0[r],p0[r+1]);b=max3f(b,p0[r+2],p0[r+3]);a=max3f(a,p1[r],p1[r+1]);b=max3f(b,p1[r+2],p1[r+3]);}
  const float m=max2f(a,b);
  auto rr=__builtin_amdgcn_permlane32_swap(__float_as_uint(m),__float_as_uint(m),false,false);
  return max2f(__uint_as_float(rr[0]),__uint_as_float(rr[1]));
}
__device__ __forceinline__ void pv(f32x16*o,int vb,bf16x8 pa0,bf16x8 pa1,bf16x8 pa2,bf16x8 pa3){
  #pragma unroll
  for(int d0=0;d0<2;++d0){s16x4 lo[4],hi[4];
    #pragma unroll
    for(int ks=0;ks<4;++ks){
      asm volatile("ds_read_b64_tr_b16 %0,%1 offset:%c2":"=&v"(lo[ks]):"v"(vb),"i"(d0*4096+ks*1024):"memory");
      asm volatile("ds_read_b64_tr_b16 %0,%1 offset:%c2":"=&v"(hi[ks]):"v"(vb),"i"(d0*4096+ks*1024+512):"memory");}
    asm volatile("s_waitcnt lgkmcnt(0)":::"memory");SBAR();
    #define PK(k) (bf16x8){lo[k][0],lo[k][1],lo[k][2],lo[k][3],hi[k][0],hi[k][1],hi[k][2],hi[k][3]}
    o[d0]=__builtin_amdgcn_mfma_f32_32x32x16_bf16(pa0,PK(0),o[d0],0,0,0);
    o[d0]=__builtin_amdgcn_mfma_f32_32x32x16_bf16(pa1,PK(1),o[d0],0,0,0);
    o[d0]=__builtin_amdgcn_mfma_f32_32x32x16_bf16(pa2,PK(2),o[d0],0,0,0);
    o[d0]=__builtin_amdgcn_mfma_f32_32x32x16_bf16(pa3,PK(3),o[d0],0,0,0);
    #undef PK
  }
}

#ifndef ATTN_STORE16
#define ATTN_STORE16(p,v) (*(u32x4*)(p)=(v))
#endif
template<int THRL,bool SPLIT> __device__ __forceinline__ void attn_unit(int b,int h,int qb,int tb_,int NT_,const bf16*QKV,bf16*O,bf16*part_o,float*part_ml,char*shm){
  const int tb=SPLIT?tb_:0, NT=SPLIT?NT_:130;
  int tid_=threadIdx.x; asm volatile("":"+v"(tid_)); const int tid=tid_,lane=tid&63,r32=lane&31,hi=lane>>5; const int wid=__builtin_amdgcn_readfirstlane(tid>>6);
  const bool meta=SPLIT; const int kvh=h>>2;
  const long rowbase=(long)b*SEQR; const long metabase=(long)MROW0+b*16;
  const bf16*Qlane=meta? QKV+(metabase+(r32&15))*PQ+(h+(wid&1)*2+(r32>>4))*D : QKV+(rowbase+qb*QB+wid*QBLK+r32)*PQ+h*D;
  const bf16*Kh=QKV+1024+kvh*D,*Vh=QKV+1280+kvh*D;
  #define TROW(t) ((tb+(t))<128?rowbase+(long)(tb+(t))*KVBLK:metabase)
  const unsigned lds0=(unsigned)(uintptr_t)shm;
  float*wsf=(float*)(shm+LDS_WS)+wid*64;
  const bf16*ksrc=Kh+(long)lane*PQ+wid*8;
  const bf16*vsrc=Vh+(long)(16*(wid&3)+(lane>>2))*PQ+(wid>>2)*32+(lane&3)*8;
  const unsigned kdst=lds0+LDS_K+wid*1024, vdst=lds0+LDS_V+wid*1024;
  #define DMA_K(t,slot) glds16(ksrc+TROW(t)*PQ,(unsigned)__builtin_amdgcn_readfirstlane(kdst+(slot)))
  #define DMA_V(t,slot) glds16(vsrc+TROW(t)*PQ,(unsigned)__builtin_amdgcn_readfirstlane(vdst+(slot)))
  const int vb0=(int)(lds0+LDS_V)+((lane>>4)&1)*32+(lane&3)*8+(4*hi+((lane&15)>>2))*64;
  const char*Kbase=shm+LDS_K; bf16x8 kf[8];
  const lds_cptr shm3=(lds_cptr)shm; const lds_cptr kp0=shm3+LDS_K+hi*1024+r32*16; const lds_cptr vp0=shm3+LDS_V+((lane>>4)&1)*32+(lane&3)*8+(4*hi+((lane&15)>>2))*64;
  DMA_K(0,0);DMA_V(0,0);DMA_K(1,SLOTB);
  bf16x8 qr[4];
  #pragma unroll
  for(int d0=0;d0<4;++d0)qr[d0]=*reinterpret_cast<const bf16x8*>(&Qlane[d0*16+hi*8]);
  float mhat=0.f,l_reg=0.f;f32x16 o[2];o[0]=f32x16{};o[1]=f32x16{};f32x16 negm=f32x16{};asm volatile("":"+v"(negm));
  #define CMASK(P0,P1,t) do{int jb_=(tb+(t))-128; if(jb_>=0)cmask(P0,P1,jb_,hi);}while(0)
  bool resc=false;
  #define START(P0,P1) do{ const float rm=rowmax(P0,P1); resc=false; \
    { const float dl=rm; mhat=fadd_s(mhat,dl); \
      _Pragma("unroll") for(int r=0;r<16;++r){P0[r]=fsub_s(P0[r],dl);P1[r]=fsub_s(P1[r],dl);} \
      _Pragma("unroll") for(int r=0;r<16;++r)negm[r]=-mhat; asm volatile("":"+v"(negm)); } \
    _Pragma("unroll") for(int r=0;r<16;++r)P0[r]=__builtin_amdgcn_exp2f(P0[r]); }while(0)
  #define RESC() do{ if(resc){ asm volatile("s_waitcnt lgkmcnt(0)":::"memory"); \
      _Pragma("unroll") for(int d_=0;d_<2;++d_) _Pragma("unroll") for(int r=0;r<16;++r)o[d_][r]*=wsf[crow(r,hi)]; } }while(0)
  f32x16 pA0,pA1,pB0,pB1;
  int sl_prev=0,sl_cur=0,sl_next=SLOTB;
  #define ROT() do{sl_prev=sl_cur;sl_cur=sl_next;sl_next=(sl_next==(NSLOT-1)*SLOTB)?0:sl_next+SLOTB;}while(0)
  DMA_K(2,2*SLOTB);
  WAIT_BAR(3);
  qkt(pA0,pA1,Kbase,qr,negm,r32,hi);asm volatile("s_nop 15\n\ts_nop 7":"+v"(pA0),"+v"(pA1));CMASK(pA0,pA1,0);
  START(pA0,pA1);
  _Pragma("unroll") for(int r=0;r<16;++r)pA1[r]=__builtin_amdgcn_exp2f(pA1[r]);
  WAIT_BAR(0);
  DMA_K(3,0);DMA_V(1,SLOTB);
  ROT();
  kload8(kf,kp0+sl_cur);
  WAIT_BAR(2);
  s16x4 vlo[8],vhi[8]; u32x4 pw0,pw1,pw2,pw3;
  #define PKW(P,B) cvtpk_s(P[B],P[B+1])
  #define PAF(k) __builtin_bit_cast(bf16x8,pw##k)
  #define VFR(i) (bf16x8){vlo[i][0],vlo[i][1],vlo[i][2],vlo[i][3],vhi[i][0],vhi[i][1],vhi[i][2],vhi[i][3]}
  #define PIN(x) asm volatile("":"+v"(x))
  #define MX3(a,b,c) __builtin_fmaxf(__builtin_fmaxf((a),(b)),(c))
  #define GAPA(MF,A0,A1,A2,A3,W0,W1,PW) do{ MF; sacc+=A0; sacc+=A1; sacc+=A2; sacc+=A3; PIN(sacc); W0; W1; PIN(PW); SBAR(); }while(0)
  #define EX(v) __builtin_amdgcn_exp2f(v)
  #define GAPB(MF,X,B) do{ MF; X[B]=EX(X[B]); X[B+1]=EX(X[B+1]); X[B+2]=EX(X[B+2]); X[B+3]=EX(X[B+3]); PIN(X); SBAR(); }while(0)
  #define VRD(i) do{ vlo[i]=vtr(vp_+(((i)>>2)*4096+((i)&3)*1024)); vhi[i]=vtr(vp_+(((i)>>2)*4096+((i)&3)*1024+512)); }while(0)
  #define KRD(G,j) do{ if(G){ kload2(kf,kp0+sl_next,j); SBAR(); } }while(0)
  #define STEP(C0,C1,P0,P1,t,GK,GV,GL) do{ SBAR(); \
    const lds_cptr vp_=vp0+sl_prev; \
    VRD(0); SBAR(); float sacc=(P0[0]+P0[1]); \
    GAPA(C0=__builtin_amdgcn_mfma_f32_32x32x16_bf16(kf[0],qr[0],negm,0,0,0), P0[2],P0[3],P0[4],P0[5],     pw0[0]=PKW(P0,0), pw0[1]=PKW(P0,2), pw0); \
    VRD(4); SBAR(); GAPA(C1=__builtin_amdgcn_mfma_f32_32x32x16_bf16(kf[1],qr[0],negm,0,0,0), P0[6],P0[7],P0[8],P0[9],     pw0[2]=PKW(P0,4), pw0[3]=PKW(P0,6), pw0); \
    VRD(1); SBAR(); GAPA(C0=__builtin_amdgcn_mfma_f32_32x32x16_bf16(kf[2],qr[1],C0,0,0,0),   P0[10],P0[11],P0[12],P0[13], pw1[0]=PKW(P0,8), pw1[1]=PKW(P0,10), pw1); \
    VRD(5); SBAR(); GAPA(C1=__builtin_amdgcn_mfma_f32_32x32x16_bf16(kf[3],qr[1],C1,0,0,0),   P0[14],P0[15],P1[0],P1[1],   pw1[2]=PKW(P0,12),pw1[3]=PKW(P0,14), pw1); \
    VRD(2); SBAR(); GAPA(C0=__builtin_amdgcn_mfma_f32_32x32x16_bf16(kf[4],qr[2],C0,0,0,0),   P1[2],P1[3],P1[4],P1[5],     pw2[0]=PKW(P1,0), pw2[1]=PKW(P1,2), pw2); \
    VRD(6); SBAR(); GAPA(C1=__builtin_amdgcn_mfma_f32_32x32x16_bf16(kf[5],qr[2],C1,0,0,0),   P1[6],P1[7],P1[8],P1[9],     pw2[2]=PKW(P1,4), pw2[3]=PKW(P1,6), pw2); \
    VRD(3); SBAR(); GAPA(C0=__builtin_amdgcn_mfma_f32_32x32x16_bf16(kf[6],qr[3],C0,0,0,0),   P1[10],P1[11],P1[12],P1[13], pw3[0]=PKW(P1,8), pw3[1]=PKW(P1,10), pw3); \
    VRD(7); SBAR(); GAPA(C1=__builtin_amdgcn_mfma_f32_32x32x16_bf16(kf[7],qr[3],C1,0,0,0),   P1[14],P1[15],0.f,0.f,       pw3[2]=PKW(P1,12),pw3[3]=PKW(P1,14), pw3); \
    l_reg+=sacc; \
    if(GK){DMA_K((t)+3,sl_cur);} if(GV){DMA_V((t)+1,sl_next);} \
    CMASK(C0,C1,t); \
    { float a=MX3(C0[0],C0[1],C1[0]),b=MX3(C0[2],C0[3],C1[1]); a=MX3(a,C1[2],C1[3]); \
      _Pragma("unroll") for(int r=4;r<16;r+=4){a=MX3(a,C0[r],C0[r+1]);b=MX3(b,C0[r+2],C0[r+3]);a=MX3(a,C1[r],C1[r+1]);b=MX3(b,C1[r+2],C1[r+3]);} \
      float rm=__builtin_fmaxf(a,b); { auto rr=__builtin_amdgcn_permlane32_swap(__float_as_uint(rm),__float_as_uint(rm),false,false); rm=__builtin_fmaxf(__uint_as_float(rr[0]),__uint_as_float(rr[1])); } \
      resc=false; \
      if(__builtin_expect(__any(rm>(float)THRL),0)){ const float dl=__builtin_fmaxf(rm,0.f); mhat+=dl; \
        _Pragma("unroll") for(int r=0;r<16;++r){C0[r]-=dl;C1[r]-=dl;} \
        _Pragma("unroll") for(int r=0;r<16;++r)negm[r]=-mhat; asm volatile("":"+v"(negm)); \
        const float f=__builtin_amdgcn_exp2f(-dl); l_reg*=f; if(hi==0)wsf[r32]=f; resc=true; } } \
    SBAR(); \
    GAPB(o[0]=__builtin_amdgcn_mfma_f32_32x32x16_bf16(PAF(0),VFR(0),o[0],0,0,0), C0,0); \
    GAPB(o[1]=__builtin_amdgcn_mfma_f32_32x32x16_bf16(PAF(0),VFR(4),o[1],0,0,0), C0,4); \
    KRD(GL,0); GAPB(o[0]=__builtin_amdgcn_mfma_f32_32x32x16_bf16(PAF(1),VFR(1),o[0],0,0,0), C0,8); \
    KRD(GL,1); GAPB(o[1]=__builtin_amdgcn_mfma_f32_32x32x16_bf16(PAF(1),VFR(5),o[1],0,0,0), C0,12); \
    KRD(GL,2); GAPB(o[0]=__builtin_amdgcn_mfma_f32_32x32x16_bf16(PAF(2),VFR(2),o[0],0,0,0), C1,0); \
    KRD(GL,3); GAPB(o[1]=__builtin_amdgcn_mfma_f32_32x32x16_bf16(PAF(2),VFR(6),o[1],0,0,0), C1,4); \
    GAPB(o[0]=__builtin_amdgcn_mfma_f32_32x32x16_bf16(PAF(3),VFR(3),o[0],0,0,0), C1,8); \
    GAPB(o[1]=__builtin_amdgcn_mfma_f32_32x32x16_bf16(PAF(3),VFR(7),o[1],0,0,0), C1,12); \
    }while(0)
  int t=1;
  #undef CMASK
  #define CMASK(P0,P1,t) do{}while(0)
  for(;t+5<NT;t+=2){
    STEP(pB0,pB1,pA0,pA1,t,true,true,true);     WAIT_BAR(2); RESC(); ROT();
    STEP(pA0,pA1,pB0,pB1,t+1,true,true,true);   WAIT_BAR(2); RESC(); ROT();
  }
  #undef CMASK
  #define CMASK(P0,P1,t) do{int jb_=(tb+(t))-128; if(jb_>=0)cmask(P0,P1,jb_,hi);}while(0)
  #define ENDW(tt) do{ if((tt)+3<NT){WAIT_BAR(2);} else if((tt)+2<NT){WAIT_BAR(1);} else {WAIT_BAR(0);} }while(0)
  for(;t+1<NT;t+=2){
    STEP(pB0,pB1,pA0,pA1,t,(t+3<NT),(t+1<NT),(t+1<NT));       ENDW(t);   RESC(); ROT();
    STEP(pA0,pA1,pB0,pB1,t+1,(t+4<NT),(t+2<NT),(t+2<NT));     ENDW(t+1); RESC(); ROT();
  }
  STEP(pB0,pB1,pA0,pA1,NT-1,false,false,false); RESC();
  { float sacc=pB0[0]+pB0[1]; _Pragma("unroll") for(int r=2;r<16;++r)sacc+=pB0[r]; _Pragma("unroll") for(int r=0;r<16;++r)sacc+=pB1[r]; l_reg+=sacc;
    pw0=(u32x4){PKW(pB0,0),PKW(pB0,2),PKW(pB0,4),PKW(pB0,6)};pw1=(u32x4){PKW(pB0,8),PKW(pB0,10),PKW(pB0,12),PKW(pB0,14)};pw2=(u32x4){PKW(pB1,0),PKW(pB1,2),PKW(pB1,4),PKW(pB1,6)};pw3=(u32x4){PKW(pB1,8),PKW(pB1,10),PKW(pB1,12),PKW(pB1,14)};
    SBAR(); pv(o,vb0+sl_cur,PAF(0),PAF(1),PAF(2),PAF(3)); }
  #undef PKW
  #undef PAF
  #undef VFR
  #undef PIN
  #undef MX3
  #undef GAPA
  #undef GAPB
  #undef EX
  #undef VRD
  #undef KRD
  #undef STEP
  #undef ENDW
  {auto rr=__builtin_amdgcn_permlane32_swap(__float_as_uint(l_reg),__float_as_uint(l_reg),false,false);l_reg=__uint_as_float(rr[0])+__uint_as_float(rr[1]);}
  if(hi==0)wsf[32+r32]=l_reg;asm volatile("s_waitcnt lgkmcnt(0)":::"memory");
  if(meta&&wid<2&&hi==0){ float*ml=part_ml+((size_t)(((b*4+(tb>>5))*16+(h+wid*2+(r32>>4)))*16+(r32&15)))*2; ml[0]=mhat; ml[1]=l_reg; }
  float rli[16];
  #pragma unroll
  for(int r=0;r<16;++r)rli[r]=__builtin_amdgcn_rcpf(wsf[32+crow(r,hi)]);
  { bf16*stg=(bf16*)(shm+LDS_OST)+wid*2048;
    #pragma unroll
    for(int r=0;r<16;++r){const int orow=crow(r,hi);
      #pragma unroll
      for(int d0=0;d0<2;++d0)stg[orow*64+d0*32+r32]=__float2bfloat16(o[d0][r]*rli[r]);}
    asm volatile("s_waitcnt lgkmcnt(0)":::"memory");
    #pragma unroll
    for(int i=0;i<4;++i){const int row=i*8+(lane>>3),ch=lane&7; const u32x4 v=*(const u32x4*)(stg+row*64+ch*8);
      bf16*op=meta? part_o+((size_t)(((b*4+(tb>>5))*16+(h+(wid&1)*2+(row>>4)))*16+(row&15)))*D+ch*8 : O+(rowbase+qb*QB+wid*QBLK+row)*PO+h*D+ch*8;
      if(!meta||wid<2) ATTN_STORE16(op,v);} }
  asm volatile("s_waitcnt lgkmcnt(0)\n\ts_barrier":::"memory");
  #undef DMA_K
  #undef TROW
  #undef DMA_V
  #undef CMASK
  #undef START
  #undef RESC
  #undef ROT
}
constexpr int ATTN_LDS_BYTES=LDS_BYTES;
#undef SBAR
#undef WAIT_BAR
}
#define LAS __attribute__((address_space(3)))
typedef unsigned short bf16_t;
typedef short bf16x8 __attribute__((ext_vector_type(8)));
typedef float f32x4 __attribute__((ext_vector_type(4)));
typedef float f32x2 __attribute__((ext_vector_type(2)));
typedef unsigned u32x2 __attribute__((ext_vector_type(2)));
typedef unsigned u32x4 __attribute__((ext_vector_type(4)));
typedef __bf16 bf16x2_t __attribute__((ext_vector_type(2)));

#ifndef PROBE_ON
#define PROBE_ON 0
#endif
#ifndef PROBE_A
#define PROBE_A 0x01
#endif
#ifndef PROBE_B
#define PROBE_B 0x10
#endif
#ifndef PG_ALIGN
#define PG_ALIGN true
#endif
#ifndef PG_SP2
#define PG_SP2 true
#endif
constexpr int NTHR = 512, NWAVES = 8;
constexpr int DMODEL = 1024, MR = 32768, NMROWS = 64, MP = 33024, SEQL = 8192, FFH = 2816;
constexpr float RMS_EPS = 1e-6f;
constexpr int LDS_BYTES = 163840;
constexpr size_t MiB = 1u << 20;
constexpr size_t OFF_W_AQKV = 0;
constexpr size_t OFF_W_AO   = 12 * MiB;
constexpr size_t OFF_W_BQKV = 16 * MiB;
constexpr size_t OFF_W_BO   = 19 * MiB;
constexpr size_t OFF_W_CIN  = 21 * MiB;
constexpr size_t OFF_W_CO   = 28 * MiB;
constexpr size_t OFF_W13    = 30 * MiB;
constexpr size_t OFF_W2     = 74 * MiB;
constexpr size_t OFF_HB     = 96 * MiB;
constexpr size_t OFF_AO     = 161 * MiB;
constexpr size_t OFF_QKV    = 226 * MiB;
constexpr size_t OFF_VT     = OFF_QKV + 129 * MiB;
constexpr size_t OFF_HX     = 436 * MiB;
constexpr size_t OFF_SS     = 444 * MiB;
constexpr size_t OFF_GATES  = 439 * MiB;
constexpr size_t OFF_ROPE   = 442 * MiB;
constexpr size_t OFF_TS     = 464 * MiB;
constexpr size_t OFF_BAR    = 465 * MiB;
constexpr size_t BAR_BYTES  = 16384;
constexpr size_t OFF_GSC    = 466 * MiB;
constexpr size_t WS_END     = 500 * MiB;
constexpr int MISC_OFF = LDS_BYTES - 128;

struct Args { const float* in[20]; float* out; unsigned char* ws; int ph_lo, ph_hi; };

__device__ __forceinline__ int opaque_tid() { int t = threadIdx.x; asm volatile("" : "+v"(t)); return t; }
__device__ __forceinline__ unsigned pk2(float lo, float hi) { f32x2 v = {lo, hi}; bf16x2_t b = __builtin_convertvector(v, bf16x2_t); return __builtin_bit_cast(unsigned, b); }
__device__ __forceinline__ float frcp(float x) { return __builtin_amdgcn_rcpf(x); }
__device__ __forceinline__ float silu_f(float x) { return x * frcp(1.f + __expf(-x)); }
__device__ __forceinline__ float bf2f(unsigned short v) { return __uint_as_float(((unsigned)v) << 16); }
__device__ __forceinline__ float bflo(unsigned w) { return __uint_as_float(w << 16); }
__device__ __forceinline__ float bfhi(unsigned w) { return __uint_as_float(w & 0xffff0000u); }
__device__ __forceinline__ f32x4 mfma16(bf16x8 a, bf16x8 b, f32x4 c) { return __builtin_amdgcn_mfma_f32_16x16x32_bf16(a, b, c, 0, 0, 0); }
__device__ __forceinline__ float rstd_of(const float* p16) { const f32x4 a = *(const f32x4*)p16, b = *(const f32x4*)(p16 + 4), c = *(const f32x4*)(p16 + 8), d = *(const f32x4*)(p16 + 12);
    const float ss = (((a[0] + a[1]) + (a[2] + a[3])) + ((b[0] + b[1]) + (b[2] + b[3]))) + (((c[0] + c[1]) + (c[2] + c[3])) + ((d[0] + d[1]) + (d[2] + d[3])));
    return rsqrtf(ss * (1.0f / 1024.0f) + RMS_EPS); }

__device__ __forceinline__ void rstd_rows8(const float* ss, int row0  , int fq, float (&rs)[8]) {
    f32x4 sv[8];
#pragma unroll
    for (int i = 0; i < 8; ++i) sv[i] = *(const f32x4*)(ss + (size_t)(row0 + (i >> 2) * 128 + (i & 3) * 16) * 16 + 4 * fq);
#pragma unroll
    for (int i = 0; i < 8; ++i) { float s = (sv[i][0] + sv[i][1]) + (sv[i][2] + sv[i][3]); s += __shfl_xor(s, 16); s += __shfl_xor(s, 32); rs[i] = rsqrtf(s * (1.0f / 1024.0f) + RMS_EPS); }
}
__device__ __forceinline__ void rstd_cols8(const float* ss, int col0, int fr, int lane, float (&rs)[8]) {
    const f32x4 a = *(const f32x4*)(ss + (size_t)col0 * 16 + 8 * fr), b = *(const f32x4*)(ss + (size_t)col0 * 16 + 8 * fr + 4);
    float s = ((a[0] + a[1]) + (a[2] + a[3])) + ((b[0] + b[1]) + (b[2] + b[3]));
    s += __shfl_xor(s, 1);
    const float r = rsqrtf(s * (1.0f / 1024.0f) + RMS_EPS);
#pragma unroll
    for (int c = 0; c < 8; ++c) rs[c] = __shfl(r, (lane & 48) | (2 * c));
}
struct EpiScaleBf16 {
    static constexpr bool PERM = true, AFTER_DRAIN = false;
    bf16_t* O; int ldc; const float* ss;
    __device__ __forceinline__ void operator()(const pg8::f32x4 (&acc)[2][2][4][2], const pg8::Unit& u, int wr, int wc, int fr_, int fq_) const {
        int fr = fr_, fq = fq_; asm volatile("" : "+v"(fr), "+v"(fq));
        float rsa[8]; rstd_rows8(ss, u.pm * 256 + wr * 64 + fr, fq, rsa);
#pragma unroll
        for (int ai = 0; ai < 2; ++ai)
#pragma unroll
            for (int m = 0; m < 4; ++m) {
                const int row = u.pm * 256 + ai * 128 + wr * 64 + m * 16 + fr;
                const float rs = rsa[ai * 4 + m];
#pragma unroll
                for (int bj = 0; bj < 2; ++bj) {
                    const int col = u.pn * 256 + bj * 128 + wc * 32 + 8 * fq;
                    const pg8::f32x4 v0 = acc[ai][bj][m][0] * rs, v1 = acc[ai][bj][m][1] * rs;
                    u32x4 w; w.x = pk2(v0[0], v0[1]); w.y = pk2(v0[2], v0[3]); w.z = pk2(v1[0], v1[1]); w.w = pk2(v1[2], v1[3]);
                    *(u32x4*)(O + (size_t)row * ldc + col) = w;
                }
            }
    }
};
struct EpiScaleColBf16 {
    static constexpr bool PERM = true, AFTER_DRAIN = false;
    bf16_t* O; int ldc; const float* ss;
    __device__ __forceinline__ void operator()(const pg8::f32x4 (&acc)[2][2][4][2], const pg8::Unit& u, int wr, int wc, int fr_, int fq_) const {
        int fr = fr_, fq = fq_; asm volatile("" : "+v"(fr), "+v"(fq));
#pragma unroll
        for (int bj = 0; bj < 2; ++bj) {
            const int col = u.pn * 256 + bj * 128 + wc * 32 + 8 * fq;
            float rc[8]; rstd_cols8(ss, col, fr, fr + 16 * fq, rc);
            pg8::f32x4 r0, r1; r0[0] = rc[0]; r0[1] = rc[1]; r0[2] = rc[2]; r0[3] = rc[3]; r1[0] = rc[4]; r1[1] = rc[5]; r1[2] = rc[6]; r1[3] = rc[7];
#pragma unroll
            for (int ai = 0; ai < 2; ++ai)
#pragma unroll
                for (int m = 0; m < 4; ++m) {
                    const int row = u.pm * 256 + ai * 128 + wr * 64 + m * 16 + fr;
                    const pg8::f32x4 v0 = acc[ai][bj][m][0] * r0, v1 = acc[ai][bj][m][1] * r1;
                    u32x4 w; w.x = pk2(v0[0], v0[1]); w.y = pk2(v0[2], v0[3]); w.z = pk2(v1[0], v1[1]); w.w = pk2(v1[2], v1[3]);
                    *(u32x4*)(O + (size_t)row * ldc + col) = w;
                }
        }
    }
};
struct EpiResid {
    static constexpr bool PERM = true, AFTER_DRAIN = false;
    bf16_t* HB; float* ssn;
    __device__ __forceinline__ void operator()(const pg8::f32x4 (&acc)[2][2][4][2], const pg8::Unit& u, int wr, int wc, int fr_, int fq_) const {
        int fr = fr_, fq = fq_; asm volatile("" : "+v"(fr), "+v"(fq));
        bf16_t* base = HB + (size_t)(u.pm * 256 + wr * 64 + fr) * 1024 + u.pn * 256 + wc * 32 + 8 * fq;
        u32x4 hw[2][4][2];
#pragma unroll
        for (int ai = 0; ai < 2; ++ai)
#pragma unroll
            for (int m = 0; m < 4; ++m)
#pragma unroll
                for (int bj = 0; bj < 2; ++bj) hw[ai][m][bj] = *(const u32x4*)(base + (size_t)(ai * 128 + m * 16) * 1024 + bj * 128);
#pragma unroll
        for (int ai = 0; ai < 2; ++ai)
#pragma unroll
            for (int m = 0; m < 4; ++m) {
                const int row = u.pm * 256 + ai * 128 + wr * 64 + m * 16 + fr;
                float sq = 0.f;
#pragma unroll
                for (int bj = 0; bj < 2; ++bj) {
                    const u32x4 h = hw[ai][m][bj]; const pg8::f32x4 a0 = acc[ai][bj][m][0], a1 = acc[ai][bj][m][1];
                    const float h0 = bflo(h.x) + a0[0], h1 = bfhi(h.x) + a0[1], h2 = bflo(h.y) + a0[2], h3 = bfhi(h.y) + a0[3];
                    const float h4 = bflo(h.z) + a1[0], h5 = bfhi(h.z) + a1[1], h6 = bflo(h.w) + a1[2], h7 = bfhi(h.w) + a1[3];
                    sq += ((h0 * h0 + h1 * h1) + (h2 * h2 + h3 * h3)) + ((h4 * h4 + h5 * h5) + (h6 * h6 + h7 * h7));
                    u32x4 w; w.x = pk2(h0, h1); w.y = pk2(h2, h3); w.z = pk2(h4, h5); w.w = pk2(h6, h7);
                    *(u32x4*)(base + (size_t)(ai * 128 + m * 16) * 1024 + bj * 128) = w;
                }
                sq += __shfl_xor(sq, 16); sq += __shfl_xor(sq, 32);
                if (fq == 0) ssn[(size_t)row * 16 + u.pn * 4 + wc] = sq;
            }
    }
};
struct EpiSwiglu {
    static constexpr bool PERM = true, AFTER_DRAIN = false;
    bf16_t* O; const float* ss;
    __device__ __forceinline__ void operator()(const pg8::f32x4 (&acc)[2][2][4][2], const pg8::Unit& u, int wr, int wc, int fr_, int fq_) const {
        int fr = fr_, fq = fq_; asm volatile("" : "+v"(fr), "+v"(fq));
        float rsa[8]; rstd_rows8(ss, u.pm * 256 + wr * 64 + fr, fq, rsa);
#pragma unroll
        for (int ai = 0; ai < 2; ++ai)
#pragma unroll
            for (int m = 0; m < 4; ++m) {
                const int row = u.pm * 256 + ai * 128 + wr * 64 + m * 16 + fr;
                const float rs = rsa[ai * 4 + m];
#pragma unroll
                for (int bj = 0; bj < 2; ++bj) {
                    const int col = u.pn * 256 + bj * 128 + wc * 32 + 8 * fq;
                    const pg8::f32x4 v0 = acc[ai][bj][m][0] * rs, v1 = acc[ai][bj][m][1] * rs;
                    const float h0 = silu_f(v0[0]) * v0[1], h1 = silu_f(v0[2]) * v0[3];
                    const float h2 = silu_f(v1[0]) * v1[1], h3 = silu_f(v1[2]) * v1[3];
                    u32x2 w; w.x = pk2(h0, h1); w.y = pk2(h2, h3);
                    *(u32x2*)(O + (size_t)row * FFH + (col >> 1)) = w;
                }
            }
    }
};
typedef __attribute__((address_space(1))) unsigned gu32;
#define XB_TMO      128
#define XB_XCNT(j)  (256  + 64 * (j))
#define XB_XSUB(j)  (1280 + 64 * (j))
#define XB_XGEN(j)  (2304 + 64 * (j))
#define XB_TOP      3328
#define XB_TOPGEN   3392
#define XCD_BAR_WORDS 3456
#define XB_SPIN_CAP (1u << 18)

__device__ __forceinline__ unsigned xb_ld(unsigned* p)              { return __hip_atomic_load(p, __ATOMIC_RELAXED, __HIP_MEMORY_SCOPE_AGENT); }
__device__ __forceinline__ unsigned xb_add(unsigned* p, unsigned v) { return __hip_atomic_fetch_add(p, v, __ATOMIC_RELAXED, __HIP_MEMORY_SCOPE_AGENT); }
__device__ __forceinline__ unsigned xb_xcc_id() { return (unsigned)__builtin_amdgcn_s_getreg((3 << 11) | 20) & 0xFu; }
#define XB_SPIN(cond, bar) do { unsigned _sp = 0; while (cond) { __builtin_amdgcn_s_sleep(1); \
    if ((++_sp & 255u) == 0u) { if (xb_ld(&(bar)[XB_TMO])) break; if (_sp > XB_SPIN_CAP) { atomicAdd(&(bar)[XB_TMO], 1u); break; } } } } while (0)

struct XcdBarrier {
    unsigned* bar; unsigned x;
    volatile LAS unsigned* st;
};

__device__ __forceinline__ XcdBarrier xcd_barrier_post(unsigned* bar, volatile LAS unsigned* st) {
    XcdBarrier b; b.bar = bar; b.x = xb_xcc_id(); b.st = st;
    if (threadIdx.x == 0) (void)xb_add(&bar[XB_XCNT(b.x)], 1u);
    return b;
}
__device__ __forceinline__ void xcd_barrier_complete(unsigned* bar, unsigned x, unsigned& nloc, unsigned& nx) {
    const unsigned G = gridDim.x * gridDim.y * gridDim.z;
    unsigned sum, cnt, mine, sp = 0u;
    for (;;) {
        sum = 0u; cnt = 0u; mine = 0u;
#pragma unroll
        for (unsigned j = 0; j < 16; ++j) { const unsigned c = xb_ld(&bar[XB_XCNT(j)]); sum += c; cnt += (c > 0u) ? 1u : 0u; mine = (j == x) ? c : mine; }
        if (sum == G) break;
        __builtin_amdgcn_s_sleep(1);
        if ((++sp & 255u) == 0u) { if (xb_ld(&bar[XB_TMO])) break; if (sp > XB_SPIN_CAP) { atomicAdd(&bar[XB_TMO], 1u); break; } }
    }
    nloc = mine > 0u ? mine : 1u; nx = cnt > 0u ? cnt : 1u;
}

__device__ __forceinline__ void xcd_barrier(const XcdBarrier& b) {
    asm volatile("s_waitcnt vmcnt(0)" ::: "memory");
    __syncthreads();
    if (threadIdx.x == 0) {
        unsigned* bar = b.bar;
        __builtin_amdgcn_s_waitcnt(0);
        unsigned nloc = b.st[0], nx = b.st[1];
        if (nloc == 0u) { xcd_barrier_complete(bar, b.x, nloc, nx); b.st[0] = nloc; b.st[1] = nx; }
        const unsigned old = xb_add(&bar[XB_XSUB(b.x)], 1u);
        const unsigned gen = old / nloc;
        if (old + 1u == (gen + 1u) * nloc) {
            __builtin_amdgcn_fence(__ATOMIC_RELEASE, "agent");
            asm volatile("s_waitcnt vmcnt(0)" ::: "memory");
            const unsigned og = xb_add(&bar[XB_TOP], 1u);
            const unsigned tg = og / nx;
            if (og + 1u == (tg + 1u) * nx) xb_add(&bar[XB_TOPGEN], 1u);
            else XB_SPIN(xb_ld(&bar[XB_TOPGEN]) == tg, bar);
            __builtin_amdgcn_fence(__ATOMIC_ACQUIRE, "agent");
            xb_add(&bar[XB_XGEN(b.x)], 1u);
            asm volatile("s_waitcnt vmcnt(0)" ::: "memory");
        } else {
            XB_SPIN(xb_ld(&bar[XB_XGEN(b.x)]) == gen, bar);
            __builtin_amdgcn_fence(__ATOMIC_ACQUIRE, "agent");
            asm volatile("s_waitcnt vmcnt(0)" ::: "memory");
        }
    }
    __syncthreads();
}
enum { SE_SCALE = 0, SE_SCALECOL = 1, SE_RESID = 2, SE_SWIGLU = 3 };
struct StripEpi { int mode; bf16_t* O; int ldc; const float* ss; float* Hx; bf16_t* HB; float* ssn; };
__device__ __forceinline__ void strip_phase(LAS unsigned char* lds, const bf16_t* __restrict__ X, const bf16_t* __restrict__ Y, int K, int njobs, bool swapped, const StripEpi E, int boff = 0) {
    const int tid = opaque_tid(), lane = tid & 63, wave = tid >> 6, l16 = lane & 15, g = lane >> 4;
    LAS float* part = (LAS float*)lds;
    const int kw = K >> 3;
    const int bsh = ((int)blockIdx.x >= boff) ? (int)blockIdx.x - boff : (int)blockIdx.x - boff + (int)gridDim.x;
    for (int jb = bsh; jb < njobs; jb += gridDim.x) {
        const int xr0 = swapped ? 64 * jb : 0, yr0 = swapped ? 0 : 64 * jb;
        const int rp_ = tid >> 3, cp_ = (tid & 7) * 8;
        f32x4 pr0 = (f32x4){0.f, 0.f, 0.f, 0.f}, pr1 = pr0, pr2 = pr0, pr3 = pr0; u32x4 phw = (u32x4){0u, 0u, 0u, 0u};
        if (E.mode == SE_SCALE || E.mode == SE_SWIGLU) { const float* sp = E.ss + (size_t)(MR + rp_) * 16; pr0 = *(const f32x4*)sp; pr1 = *(const f32x4*)(sp + 4); pr2 = *(const f32x4*)(sp + 8); pr3 = *(const f32x4*)(sp + 12); }
        if (E.mode == SE_RESID) phw = *(const u32x4*)(E.HB + (size_t)(MR + rp_) * 1024 + 64 * jb + cp_);
        const float prs = rsqrtf(((((pr0[0] + pr0[1]) + (pr0[2] + pr0[3])) + ((pr1[0] + pr1[1]) + (pr1[2] + pr1[3]))) + (((pr2[0] + pr2[1]) + (pr2[2] + pr2[3])) + ((pr3[0] + pr3[1]) + (pr3[2] + pr3[3])))) * (1.0f / 1024.0f) + RMS_EPS);
        const bf16_t* xp = X + (size_t)(xr0 + l16) * K + wave * kw + 8 * g;
        const bf16_t* yp = Y + (size_t)(yr0 + l16) * K + wave * kw + 8 * g;
        f32x4 acc[4][4];
#pragma unroll
        for (int a = 0; a < 4; ++a)
#pragma unroll
            for (int b = 0; b < 4; ++b) acc[a][b] = (f32x4){0.f, 0.f, 0.f, 0.f};
#pragma unroll 4
        for (int k = 0; k < kw; k += 32) {
            bf16x8 af[4], bf[4];
#pragma unroll
            for (int a = 0; a < 4; ++a) { af[a] = *(const bf16x8*)(xp + (size_t)a * 16 * K + k); bf[a] = *(const bf16x8*)(yp + (size_t)a * 16 * K + k); }
#pragma unroll
            for (int a = 0; a < 4; ++a)
#pragma unroll
                for (int b = 0; b < 4; ++b) acc[a][b] = mfma16(af[a], bf[b], acc[a][b]);
        }
#pragma unroll
        for (int a = 0; a < 4; ++a)
#pragma unroll
            for (int b = 0; b < 4; ++b)
#pragma unroll
                for (int e = 0; e < 4; ++e) part[wave * 4096 + (16 * a + 4 * g + e) * 64 + 16 * b + l16] = acc[a][b][e];
        __syncthreads();
        const int r = tid >> 3, c0 = (tid & 7) * 8;
        f32x4 s0 = (f32x4){0.f, 0.f, 0.f, 0.f}, s1 = s0;
#pragma unroll
        for (int w = 0; w < 8; ++w) { const f32x4 p0 = *(const LAS f32x4*)(part + w * 4096 + r * 64 + c0), p1 = *(const LAS f32x4*)(part + w * 4096 + r * 64 + c0 + 4);
            s0[0] += p0[0]; s0[1] += p0[1]; s0[2] += p0[2]; s0[3] += p0[3]; s1[0] += p1[0]; s1[1] += p1[1]; s1[2] += p1[2]; s1[3] += p1[3]; }
        if (E.mode == SE_SCALE) {
            const int row = MR + r; const float rs = prs;
            u32x4 o; o.x = pk2(s0[0] * rs, s0[1] * rs); o.y = pk2(s0[2] * rs, s0[3] * rs); o.z = pk2(s1[0] * rs, s1[1] * rs); o.w = pk2(s1[2] * rs, s1[3] * rs);
            *(u32x4*)(E.O + (size_t)row * E.ldc + 64 * jb + c0) = o;
        } else if (E.mode == SE_SCALECOL) {
            const int f = 64 * jb + r, t0 = MR + c0; float rs[8];
#pragma unroll
            for (int i = 0; i < 8; ++i) rs[i] = rstd_of(E.ss + (size_t)(t0 + i) * 16);
            u32x4 o; o.x = pk2(s0[0] * rs[0], s0[1] * rs[1]); o.y = pk2(s0[2] * rs[2], s0[3] * rs[3]); o.z = pk2(s1[0] * rs[4], s1[1] * rs[5]); o.w = pk2(s1[2] * rs[6], s1[3] * rs[7]);
            *(u32x4*)(E.O + (size_t)f * E.ldc + t0) = o;
        } else if (E.mode == SE_RESID) {
            const u32x4 hw = phw;
            f32x4 h0, h1; h0[0] = bflo(hw.x) + s0[0]; h0[1] = bfhi(hw.x) + s0[1]; h0[2] = bflo(hw.y) + s0[2]; h0[3] = bfhi(hw.y) + s0[3]; h1[0] = bflo(hw.z) + s1[0]; h1[1] = bfhi(hw.z) + s1[1]; h1[2] = bflo(hw.w) + s1[2]; h1[3] = bfhi(hw.w) + s1[3];
            u32x4 o; o.x = pk2(h0[0], h0[1]); o.y = pk2(h0[2], h0[3]); o.z = pk2(h1[0], h1[1]); o.w = pk2(h1[2], h1[3]);
            *(u32x4*)(E.HB + (size_t)(MR + r) * 1024 + 64 * jb + c0) = o;
            float sq = ((h0[0] * h0[0] + h0[1] * h0[1]) + (h0[2] * h0[2] + h0[3] * h0[3])) + ((h1[0] * h1[0] + h1[1] * h1[1]) + (h1[2] * h1[2] + h1[3] * h1[3]));
            sq += __shfl_xor(sq, 1); sq += __shfl_xor(sq, 2); sq += __shfl_xor(sq, 4);
            if ((tid & 7) == 0) E.ssn[(size_t)(MR + r) * 16 + jb] = sq;
        } else {
            const int row = MR + r; const float rs = prs;
            const float g0 = s0[0] * rs, g1 = s0[2] * rs, g2 = s1[0] * rs, g3 = s1[2] * rs;
            const float o0 = silu_f(g0) * (s0[1] * rs), o1 = silu_f(g1) * (s0[3] * rs), o2 = silu_f(g2) * (s1[1] * rs), o3 = silu_f(g3) * (s1[3] * rs);
            u32x2 o; o.x = pk2(o0, o1); o.y = pk2(o2, o3);
            *(u32x2*)(E.O + (size_t)row * FFH + ((64 * jb + c0) >> 1)) = o;
        }
        __syncthreads();
    }
}
__device__ __forceinline__ void gates_phase(const bf16_t* __restrict__ HB, const bf16_t* __restrict__ Wg, const float* __restrict__ ss, float* __restrict__ gates) {
    const int tid = opaque_tid(), lane = tid & 63, wave = tid >> 6, l16 = lane & 15, g = lane >> 4;
    const int gw = blockIdx.x * NWAVES + wave, NGW = gridDim.x * NWAVES;
    for (int rt = gw; rt < (MR + NMROWS) / 16; rt += NGW) {
        const bf16_t* xp = HB + (size_t)(16 * rt + l16) * 1024 + 8 * g; const bf16_t* yp = Wg + (size_t)l16 * 1024 + 8 * g;
        f32x4 acc = (f32x4){0.f, 0.f, 0.f, 0.f};
        for (int k0 = 0; k0 < 1024; k0 += 256) {
            bf16x8 af[8], bf[8];
#pragma unroll
            for (int i = 0; i < 8; ++i) { af[i] = *(const bf16x8*)(xp + k0 + 32 * i); bf[i] = *(const bf16x8*)(yp + k0 + 32 * i); }
#pragma unroll
            for (int i = 0; i < 8; ++i) acc = mfma16(af[i], bf[i], acc);
        }
#pragma unroll
        for (int e = 0; e < 4; ++e) { const int row = 16 * rt + 4 * g + e; gates[(size_t)row * 16 + l16] = acc[e] * rstd_of(ss + (size_t)row * 16); }
    }
}
__device__ __forceinline__ float wave_sum(float v) {
#pragma unroll
    for (int o = 1; o < 64; o <<= 1) v += __shfl_xor(v, o);
    return v;
}
__device__ __forceinline__ void transpose_item(const float* W, int Npitch, int K, int nblk, const float* g, bf16_t* WT, int row_off, int row_mul, LAS float* scr, int item, int lane) {
    const int kb = item / nblk, nb = item % nblk, k0 = 64 * kb, n0 = 32 * nb;
    float wv[32];
#pragma unroll
    for (int i = 0; i < 32; ++i) wv[i] = __builtin_nontemporal_load(W + (size_t)(k0 + 2 * i + (lane >> 5)) * Npitch + n0 + (lane & 31));
#pragma unroll
    for (int i = 0; i < 32; ++i) { const int kk = 2 * i + (lane >> 5); const float gv = g ? g[k0 + kk] : 1.f; scr[kk * 33 + (lane & 31)] = wv[i] * gv; }
    asm volatile("s_waitcnt lgkmcnt(0)" ::: "memory");
    const int c = lane & 7;
#pragma unroll
    for (int j = 0; j < 4; ++j) { const int n = (lane >> 3) + 8 * j; const LAS float* s = scr + (8 * c) * 33 + n;
        u32x4 o; o.x = pk2(s[0 * 33], s[1 * 33]); o.y = pk2(s[2 * 33], s[3 * 33]); o.z = pk2(s[4 * 33], s[5 * 33]); o.w = pk2(s[6 * 33], s[7 * 33]);
        *(u32x4*)(WT + (size_t)(row_off + (n0 + n) * row_mul) * K + k0 + 8 * c) = o; }
    asm volatile("s_waitcnt lgkmcnt(0)" ::: "memory");
}
template <int PART>
__device__ __forceinline__ void weight_items(const Args& a, LAS unsigned char* lds, int blk, int nblk) {
    const int tid = opaque_tid(), lane = tid & 63, wave = tid >> 6;
    const int gw = blk * NWAVES + wave, NGW = nblk * NWAVES;
    LAS float* scr = (LAS float*)(lds + wave * 16384);
    unsigned char* ws = a.ws;
    const float* nmix = a.in[2]; const float* nffn = a.in[3];
    constexpr int I_AQKV = 16 * 96, I_SQ = 16 * 32, I_BQKV = 16 * 48, I_CIN = 16 * 96, I_W1 = 16 * 88, I_W2 = 44 * 32, I_FFN = 2 * I_W1 + I_W2;
    constexpr int NITEMS = (PART == 0) ? (I_AQKV + I_SQ + I_BQKV + I_SQ + 2 * I_FFN) : (I_AQKV + I_SQ + I_CIN + I_SQ + 2 * I_FFN);
    for (int it = gw; it < NITEMS; it += NGW) {
        int r = it;
#define TRI(NIT, W, NP, KK, NBLK, G, WT, RO, RM) if (r < (NIT)) { transpose_item(W, NP, KK, NBLK, G, (bf16_t*)(WT), RO, RM, scr, r, lane); continue; } r -= (NIT);
        if (PART == 0) {
            TRI(I_AQKV, a.in[5], 3072, 1024, 96, nmix, ws + OFF_W_AQKV, 0, 1)
            TRI(I_SQ, a.in[8], 1024, 1024, 32, nullptr, ws + OFF_W_AO, 0, 1)
            TRI(I_BQKV, a.in[9], 1536, 1024, 48, nmix + 1024, ws + OFF_W_BQKV, 0, 1)
            TRI(I_SQ, a.in[12], 1024, 1024, 32, nullptr, ws + OFF_W_BO, 0, 1)
        } else {
            TRI(I_AQKV, a.in[5] + (size_t)1024 * 3072, 3072, 1024, 96, nmix + 3 * 1024, ws + OFF_W_AQKV + 6 * MiB, 0, 1)
            TRI(I_SQ, a.in[8] + (size_t)1024 * 1024, 1024, 1024, 32, nullptr, ws + OFF_W_AO + 2 * MiB, 0, 1)
            TRI(I_CIN, a.in[13], 3088, 1024, 96, nmix + 2048, ws + OFF_W_CIN, 0, 1)
            TRI(I_SQ, a.in[16], 1024, 1024, 32, nullptr, ws + OFF_W_CO, 0, 1)
        }
        { const int li = 2 * PART + r / I_FFN; r -= (li - 2 * PART) * I_FFN;
          TRI(I_W1, a.in[17] + (size_t)li * 1024 * FFH, FFH, 1024, 88, nffn + li * 1024, ws + OFF_W13 + (size_t)li * 11 * MiB, 0, 2)
          TRI(I_W1, a.in[18] + (size_t)li * 1024 * FFH, FFH, 1024, 88, nffn + li * 1024, ws + OFF_W13 + (size_t)li * 11 * MiB, 1, 2)
          transpose_item(a.in[19] + (size_t)li * FFH * 1024, 1024, FFH, 32, nullptr, (bf16_t*)(ws + OFF_W2 + (size_t)li * 11 * MiB / 2), 0, 1, scr, r, lane); }
#undef TRI
    }
    if (PART == 1) {
        bf16_t* wc = (bf16_t*)(ws + OFF_W_CIN); const float* W = a.in[13]; const float* g = nmix + 2048;
        if (blk < 16) {
            const int n = 3072 + blk;
#pragma unroll
            for (int q = 0; q < 2; ++q) { const int k = tid + NTHR * q; wc[(size_t)n * 1024 + k] = (bf16_t)(pk2(W[(size_t)k * 3088 + n] * g[k], 0.f) & 0xffffu); } }
    }
}
__device__ __forceinline__ void prologue_phase(const Args& a, LAS unsigned char* lds) {
    weight_items<0>(a, lds, blockIdx.x, gridDim.x);
    const int tid = opaque_tid(), lane = tid & 63, wave = tid >> 6;
    const int gw = blockIdx.x * NWAVES + wave, NGW = gridDim.x * NWAVES;
    unsigned char* ws = a.ws;
    const int gt = blockIdx.x * NTHR + tid, NGT = gridDim.x * NTHR;
    { f32x2* tab = (f32x2*)(ws + OFF_ROPE);
      for (int i = gt; i < 128 * 16; i += NGT) { const int pos = i >> 4, fi = i & 15; const float freq = 1.0f / powf(10000.0f, (float)fi * (1.0f / 16.0f)); const float ang = (float)pos * freq;
          const double tw = 6.283185307179586476925; const double rr = (double)ang - tw * rint((double)ang / tw); const float rf = (float)rr;
          tab[i] = (f32x2){__cosf(rf), __sinf(rf)}; } }
    { float* ss0 = (float*)(ws + OFF_SS); bf16_t* HB = (bf16_t*)(ws + OFF_HB); bf16_t* AO = (bf16_t*)(ws + OFF_AO);
      for (int row0 = gw; row0 < MR; row0 += 4 * NGW) {
          f32x4 v[4][4];
#pragma unroll
          for (int q = 0; q < 4; ++q) { const int row = row0 + q * NGW;
#pragma unroll
              for (int j = 0; j < 4; ++j) v[q][j] = (row < MR) ? __builtin_nontemporal_load((const f32x4*)(a.in[0] + (size_t)row * 1024 + 256 * j + 4 * lane)) : (f32x4){0.f, 0.f, 0.f, 0.f}; }
#pragma unroll
          for (int q = 0; q < 4; ++q) { const int row = row0 + q * NGW; if (row < MR) { float s = 0.f;
#pragma unroll
              for (int j = 0; j < 4; ++j) { const f32x4 x = v[q][j]; s += (x[0] * x[0] + x[1] * x[1]) + (x[2] * x[2] + x[3] * x[3]);
                  u32x2 w; w.x = pk2(x[0], x[1]); w.y = pk2(x[2], x[3]); *(u32x2*)(HB + (size_t)row * 1024 + 256 * j + 4 * lane) = w; }
              s = wave_sum(s); if (lane < 16) ss0[(size_t)row * 16 + lane] = (lane == 0) ? s : 0.f; } } }
      for (int row = MR + gw; row < MP; row += NGW) {
          const bool meta = row < MR + NMROWS;
          const float* src = a.in[1] + (size_t)((row - MR) & 15) * 1024;
          float s = 0.f;
#pragma unroll
          for (int j = 0; j < 4; ++j) { f32x4 v = (f32x4){0.f, 0.f, 0.f, 0.f}; if (meta) v = *(const f32x4*)(src + 256 * j + 4 * lane);
              s += (v[0] * v[0] + v[1] * v[1]) + (v[2] * v[2] + v[3] * v[3]);
              u32x2 w; w.x = pk2(v[0], v[1]); w.y = pk2(v[2], v[3]); *(u32x2*)(HB + (size_t)row * 1024 + 256 * j + 4 * lane) = w;
              if (!meta) *(u32x2*)(AO + (size_t)row * 1024 + 256 * j + 4 * lane) = (u32x2){0u, 0u}; }
          s = wave_sum(s); if (lane < 16) ss0[(size_t)row * 16 + lane] = (lane == 0) ? s : 0.f; } }
}

template <bool META>
__device__ __forceinline__ void na_unit(const bf16_t* __restrict__ QK, const bf16_t* __restrict__ VT, const float* __restrict__ relb, const float* __restrict__ metab, bf16_t* __restrict__ AO, int b, int h, int r, int j, int lane) {
    const int l16 = lane & 15, g = lane >> 4;
    const int qcol = META ? 0 : 16 * j + l16;
    const long mrow0 = (long)MR + b * 16;
    const long qrow = META ? mrow0 + l16 : (long)b * SEQL + r * 64 + qcol;
    const bf16_t* qp = QK + qrow * 2048 + h * 64 + 8 * g;
    const bf16x8 qf0 = *(const bf16x8*)qp, qf1 = *(const bf16x8*)(qp + 32);
    f32x4 sm;
    { const bf16_t* kp = QK + (mrow0 + l16) * 2048 + 1024 + h * 64 + 8 * g;
      const bf16x8 k0 = *(const bf16x8*)kp, k1 = *(const bf16x8*)(kp + 32);
      f32x4 acc = (f32x4){0.f, 0.f, 0.f, 0.f}; acc = mfma16(k0, qf0, acc); acc = mfma16(k1, qf1, acc);
#pragma unroll
      for (int e = 0; e < 4; ++e) sm[e] = acc[e] * 0.125f + metab[4 * g + e]; }
    float mx = fmaxf(fmaxf(sm[0], sm[1]), fmaxf(sm[2], sm[3]));
    f32x4 s[8][2];
    const int kstart = (j == 0) ? 0 : (j == 1) ? 8 : (j == 2) ? 24 : 32;
    const int rs = min(max(r - 4, 0), 120);
    if (!META) {
        const int qs = min(max(qcol - 8, 0), 48);
        const int kc0 = kstart + 8 * (l16 >> 2) + (l16 & 3);
#pragma unroll
        for (int i = 0; i < 8; ++i) {
            const long krow = (long)b * SEQL + (rs + i) * 64;
            const bf16_t* kp0 = QK + (krow + kc0) * 2048 + 1024 + h * 64 + 8 * g;
            const bf16_t* kp1 = kp0 + 4 * 2048;
            f32x4 a0 = (f32x4){0.f, 0.f, 0.f, 0.f}, a1 = (f32x4){0.f, 0.f, 0.f, 0.f};
            a0 = mfma16(*(const bf16x8*)kp0, qf0, a0); a0 = mfma16(*(const bf16x8*)(kp0 + 32), qf1, a0);
            a1 = mfma16(*(const bf16x8*)kp1, qf0, a1); a1 = mfma16(*(const bf16x8*)(kp1 + 32), qf1, a1);
            const float* rb = relb + (rs + i - r + 7) * 31;
#pragma unroll
            for (int e = 0; e < 4; ++e) {
                const int kc = kstart + 8 * g + e, kd = kc + 4;
                const bool v0 = (kc >= qs) && (kc < qs + 16), v1 = (kd >= qs) && (kd < qs + 16);
                const int dc0 = min(max(kc - qcol + 15, 0), 30), dc1 = min(max(kd - qcol + 15, 0), 30);
                const float b0 = rb[dc0], b1 = rb[dc1];
                s[i][0][e] = v0 ? a0[e] * 0.125f + b0 : -INFINITY;
                s[i][1][e] = v1 ? a1[e] * 0.125f + b1 : -INFINITY;
                mx = fmaxf(mx, fmaxf(s[i][0][e], s[i][1][e]));
            }
        }
    }
    mx = fmaxf(mx, __shfl_xor(mx, 16)); mx = fmaxf(mx, __shfl_xor(mx, 32));
    float sum = 0.f;
#pragma unroll
    for (int e = 0; e < 4; ++e) { sm[e] = __expf(sm[e] - mx); sum += sm[e]; }
    if (!META) {
#pragma unroll
        for (int i = 0; i < 8; ++i)
#pragma unroll
            for (int e = 0; e < 4; ++e) { s[i][0][e] = __expf(s[i][0][e] - mx); s[i][1][e] = __expf(s[i][1][e] - mx); sum += s[i][0][e] + s[i][1][e]; }
    }
    sum += __shfl_xor(sum, 16); sum += __shfl_xor(sum, 32);
    const float inv = 1.0f / sum;
    f32x4 o[4];
#pragma unroll
    for (int dt = 0; dt < 4; ++dt) o[dt] = (f32x4){0.f, 0.f, 0.f, 0.f};
    if (!META) {
#pragma unroll
        for (int i = 0; i < 8; ++i) {
            u32x4 pw; pw.x = pk2(s[i][0][0] * inv, s[i][0][1] * inv); pw.y = pk2(s[i][0][2] * inv, s[i][0][3] * inv); pw.z = pk2(s[i][1][0] * inv, s[i][1][1] * inv); pw.w = pk2(s[i][1][2] * inv, s[i][1][3] * inv);
            const bf16x8 pf = __builtin_bit_cast(bf16x8, pw);
            const size_t tok = (size_t)b * SEQL + (rs + i) * 64 + kstart + 8 * g;
#pragma unroll
            for (int dt = 0; dt < 4; ++dt) { const bf16x8 vf = *(const bf16x8*)(VT + (size_t)(h * 64 + dt * 16 + l16) * MP + tok); o[dt] = mfma16(vf, pf, o[dt]); }
        }
    }
    { u32x4 pw; pw.x = pk2(sm[0] * inv, sm[1] * inv); pw.y = pk2(sm[2] * inv, sm[3] * inv); pw.z = 0u; pw.w = 0u;
      const bf16x8 pf = __builtin_bit_cast(bf16x8, pw);
#pragma unroll
      for (int dt = 0; dt < 4; ++dt) { const u32x2 v2 = *(const u32x2*)(VT + (size_t)(h * 64 + dt * 16 + l16) * MP + mrow0 + 4 * g);
          u32x4 vw; vw.x = v2.x; vw.y = v2.y; vw.z = 0u; vw.w = 0u; o[dt] = mfma16(__builtin_bit_cast(bf16x8, vw), pf, o[dt]); } }
#pragma unroll
    for (int dt = 0; dt < 4; ++dt) { u32x2 w; w.x = pk2(o[dt][0], o[dt][1]); w.y = pk2(o[dt][2], o[dt][3]); *(u32x2*)(AO + qrow * 1024 + h * 64 + dt * 16 + 4 * g) = w; }
}
constexpr int NA_KP = 72, NA_VP = 584, NA_SVT = 576 * NA_KP * 2, NA_SB = NA_SVT + 64 * NA_VP * 2;
__device__ __forceinline__ void na_unit_lds(LAS unsigned char* lds, bf16_t* __restrict__ AO, int b, int h, int r, int j, int lane, bf16x8 qf0, bf16x8 qf1, bf16x8 mk0, bf16x8 mk1, const u32x2 (&mv)[4]) {
    const LAS bf16_t* sK = (const LAS bf16_t*)lds; const LAS bf16_t* sVt = (const LAS bf16_t*)(lds + NA_SVT); const LAS float* sB = (const LAS float*)(lds + NA_SB);
    const int l16 = lane & 15, g = lane >> 4;
    const float QS2 = 0.125f * 1.4426950408889634f;
    const int qcol = 16 * j + l16;
    const long mrow0 = (long)MR + b * 16;
    const long qrow = (long)b * SEQL + r * 64 + qcol;
    f32x4 sm;
    { f32x4 acc = (f32x4){0.f, 0.f, 0.f, 0.f}; acc = mfma16(mk0, qf0, acc); acc = mfma16(mk1, qf1, acc);
#pragma unroll
      for (int e = 0; e < 4; ++e) sm[e] = acc[e] * QS2 + sB[465 + 4 * g + e]; }
    float mx = fmaxf(fmaxf(sm[0], sm[1]), fmaxf(sm[2], sm[3]));
    f32x4 s[8][2];
    const int kstart = (j == 0) ? 0 : (j == 1) ? 8 : (j == 2) ? 24 : 32;
    const int rs = min(max(r - 4, 0), 120), rs9 = rs % 9;
    const int qs = min(max(qcol - 8, 0), 48);
    const int kc0 = kstart + 8 * (l16 >> 2) + (l16 & 3);
    const int kb = kstart + 8 * g, dcb = kb - qcol + 15;
    float msk[8];
#pragma unroll
    for (int c = 0; c < 8; ++c) msk[c] = ((kb + c >= qs) && (kb + c < qs + 16)) ? INFINITY : -INFINITY;
#pragma unroll
    for (int i = 0; i < 8; ++i) {
        const int sl = (rs9 + i >= 9) ? rs9 + i - 9 : rs9 + i;
        const LAS bf16_t* kp0 = sK + (sl * 64 + kc0) * NA_KP + 8 * g;
        const LAS bf16_t* kp1 = kp0 + 4 * NA_KP;
        f32x4 a0 = (f32x4){0.f, 0.f, 0.f, 0.f}, a1 = (f32x4){0.f, 0.f, 0.f, 0.f};
        a0 = mfma16(*(const LAS bf16x8*)kp0, qf0, a0); a0 = mfma16(*(const LAS bf16x8*)(kp0 + 32), qf1, a0);
        a1 = mfma16(*(const LAS bf16x8*)kp1, qf0, a1); a1 = mfma16(*(const LAS bf16x8*)(kp1 + 32), qf1, a1);
        const LAS float* rb = sB + (rs + i - r + 7) * 31 + dcb;
#pragma unroll
        for (int e = 0; e < 4; ++e) {
            const float b0 = rb[e], b1 = rb[4 + e];
            s[i][0][e] = fminf(a0[e] * QS2 + b0, msk[e]);
            s[i][1][e] = fminf(a1[e] * QS2 + b1, msk[4 + e]);
            mx = fmaxf(mx, fmaxf(s[i][0][e], s[i][1][e]));
        }
    }
    mx = fmaxf(mx, __shfl_xor(mx, 16)); mx = fmaxf(mx, __shfl_xor(mx, 32));
    float sum = 0.f;
#pragma unroll
    for (int e = 0; e < 4; ++e) { sm[e] = __builtin_amdgcn_exp2f(sm[e] - mx); sum += sm[e]; }
#pragma unroll
    for (int i = 0; i < 8; ++i)
#pragma unroll
        for (int e = 0; e < 4; ++e) { s[i][0][e] = __builtin_amdgcn_exp2f(s[i][0][e] - mx); s[i][1][e] = __builtin_amdgcn_exp2f(s[i][1][e] - mx); sum += s[i][0][e] + s[i][1][e]; }
    sum += __shfl_xor(sum, 16); sum += __shfl_xor(sum, 32);
    const float inv = 1.0f / sum;
    f32x4 o[4];
#pragma unroll
    for (int dt = 0; dt < 4; ++dt) o[dt] = (f32x4){0.f, 0.f, 0.f, 0.f};
#pragma unroll
    for (int i = 0; i < 8; ++i) {
        u32x4 pw; pw.x = pk2(s[i][0][0], s[i][0][1]); pw.y = pk2(s[i][0][2], s[i][0][3]); pw.z = pk2(s[i][1][0], s[i][1][1]); pw.w = pk2(s[i][1][2], s[i][1][3]);
        const bf16x8 pf = __builtin_bit_cast(bf16x8, pw);
        const int sl = (rs9 + i >= 9) ? rs9 + i - 9 : rs9 + i;
        const int tk = sl * 64 + kstart + 8 * g;
#pragma unroll
        for (int dt = 0; dt < 4; ++dt) { const bf16x8 vf = *(const LAS bf16x8*)(sVt + (dt * 16 + l16) * NA_VP + tk); o[dt] = mfma16(vf, pf, o[dt]); }
    }
    { u32x4 pw; pw.x = pk2(sm[0], sm[1]); pw.y = pk2(sm[2], sm[3]); pw.z = 0u; pw.w = 0u;
      const bf16x8 pf = __builtin_bit_cast(bf16x8, pw);
#pragma unroll
      for (int dt = 0; dt < 4; ++dt) { u32x4 vw; vw.x = mv[dt].x; vw.y = mv[dt].y; vw.z = 0u; vw.w = 0u; o[dt] = mfma16(__builtin_bit_cast(bf16x8, vw), pf, o[dt]); } }
#pragma unroll
    for (int dt = 0; dt < 4; ++dt) { u32x2 w; w.x = pk2(o[dt][0] * inv, o[dt][1] * inv); w.y = pk2(o[dt][2] * inv, o[dt][3] * inv); *(u32x2*)(AO + qrow * 1024 + h * 64 + dt * 16 + 4 * g) = w; }
}
__device__ __forceinline__ void na_phase(LAS unsigned char* lds, const bf16_t* QK, const bf16_t* VT, const float* relb, const float* metab, bf16_t* AO) {
    const int tid = opaque_tid(), lane = tid & 63, wave = tid >> 6;
    LAS bf16_t* sK = (LAS bf16_t*)lds; LAS bf16_t* sVt = (LAS bf16_t*)(lds + NA_SVT); LAS float* sB = (LAS float*)(lds + NA_SB);
    { int tz = tid; unsigned z; asm volatile("v_mov_b32 %0, 0" : "=v"(z), "+v"(tz));
      if (tz < 64) { LAS unsigned* pz = (LAS unsigned*)(sVt + tz * NA_VP + 576); pz[0] = z; pz[1] = z; pz[2] = z; pz[3] = z; } }
    for (int sg = blockIdx.x; sg < 256; sg += gridDim.x) {
        const int qd = sg & 3, h = (sg >> 2) & 15, b = sg >> 6;
        const size_t tokb = (size_t)b * SEQL;
        const bf16_t* Kg = QK + 1024 + h * 64; const bf16_t* Vg = VT + (size_t)(h * 64) * MP;
        { const int rsA = min(max(32 * qd - 4, 0), 120);
          int t0_ = tid; asm volatile("" : "+v"(t0_));
          if (t0_ < 465) sB[t0_] = relb[h * 465 + t0_] * 1.4426950408889634f; else if (t0_ < 481) sB[t0_] = metab[h * 16 + t0_ - 465] * 1.4426950408889634f;
#pragma unroll 9
          for (int i = 0; i < 9; ++i) { const int q = t0_ + NTHR * i; const int key = q >> 3, ch = q & 7; const int R = rsA + (key >> 6), sl = R % 9;
              const u32x4 v = *(const u32x4*)(Kg + (tokb + (size_t)R * 64 + (key & 63)) * 2048 + ch * 8); *(LAS u32x4*)(sK + (sl * 64 + (key & 63)) * NA_KP + ch * 8) = v; }
#pragma unroll 9
          for (int i = 0; i < 9; ++i) { const int q = t0_ + NTHR * i; const int d = q / 72, c = q - d * 72; const int R = rsA + (c >> 3), sl = R % 9;
              const u32x4 v = *(const u32x4*)(Vg + (size_t)d * MP + tokb + (size_t)R * 64 + (c & 7) * 8); *(LAS u32x4*)(sVt + d * NA_VP + sl * 64 + (c & 7) * 8) = v; }
        }
        const int l16 = lane & 15, g4 = lane >> 4; const long mrow0 = (long)MR + b * 16;
        bf16x8 mk0, mk1; u32x2 mv[4];
        { const bf16_t* kp = QK + (mrow0 + l16) * 2048 + 1024 + h * 64 + 8 * g4; mk0 = *(const bf16x8*)kp; mk1 = *(const bf16x8*)(kp + 32);
#pragma unroll
          for (int dt = 0; dt < 4; ++dt) mv[dt] = *(const u32x2*)(Vg + (size_t)(dt * 16 + l16) * MP + mrow0 + 4 * g4); }
        const bf16_t* qbase = QK + (tokb + (size_t)(32 * qd + (wave >> 2)) * 64 + 16 * (wave & 3) + l16) * 2048 + h * 64 + 8 * g4;
        bf16x8 qf0 = *(const bf16x8*)qbase, qf1 = *(const bf16x8*)(qbase + 32);
        __syncthreads();
        for (int u = 0; u < 16; ++u) {
            const int r0 = 2 * (16 * qd + u), rsA = min(max(r0 - 4, 0), 120), rsN = min(max(r0 - 2, 0), 120);
            const bool more = (u < 15) && (rsN != rsA);
            int ts = tid; asm volatile("" : "+v"(ts));
            u32x4 pk0, pk1, pv0, pv1; pk0 = pk1 = pv0 = pv1 = (u32x4){0u, 0u, 0u, 0u};
            const int kq = ts >> 3, kch = ts & 7;
            if (more) { const size_t t0 = tokb + (size_t)(rsA + 9) * 64;
                pk0 = *(const u32x4*)(Kg + (t0 + kq) * 2048 + kch * 8); pk1 = *(const u32x4*)(Kg + (t0 + 64 + kq) * 2048 + kch * 8);
                pv0 = *(const u32x4*)(Vg + (size_t)kq * MP + t0 + kch * 8); pv1 = *(const u32x4*)(Vg + (size_t)kq * MP + t0 + 64 + kch * 8); }
            bf16x8 nq0 = qf0, nq1 = qf1;
            if (u < 15) { const bf16_t* qn = qbase + (size_t)(u + 1) * 128 * 2048; nq0 = *(const bf16x8*)qn; nq1 = *(const bf16x8*)(qn + 32); }
            { const int r = r0 + (wave >> 2), j = wave & 3; int ln = lane; asm volatile("" : "+v"(ln)); na_unit_lds(lds, AO, b, h, r, j, ln, qf0, qf1, mk0, mk1, mv); }
            qf0 = nq0; qf1 = nq1;
            __syncthreads();
            if (more) { const int s0 = rsA % 9, s1 = (rsA + 1) % 9;
                *(LAS u32x4*)(sK + (s0 * 64 + kq) * NA_KP + kch * 8) = pk0; *(LAS u32x4*)(sK + (s1 * 64 + kq) * NA_KP + kch * 8) = pk1;
                *(LAS u32x4*)(sVt + kq * NA_VP + s0 * 64 + kch * 8) = pv0; *(LAS u32x4*)(sVt + kq * NA_VP + s1 * 64 + kch * 8) = pv1; }
            __syncthreads();
        }
    }
    for (int mu = blockIdx.x * NWAVES + wave; mu < 64; mu += gridDim.x * NWAVES) { const int b = mu >> 4, h = mu & 15;
        na_unit<true>(QK, VT, relb + h * 465, metab + h * 16, AO, b, h, 0, 0, lane); }
}

__device__ __forceinline__ void rope_phase(bf16_t* QKV, bf16_t* DST, const float* qn, const float* kn, const f32x2* tab) {
    const int tid = opaque_tid(), lane = tid & 63, wave = tid >> 6, l16 = lane & 15, hq = lane >> 4;
    const int gw = blockIdx.x * NWAVES + wave, NGW = gridDim.x * NWAVES;
    const float C2 = 0.125f * 1.4426950408889634f;
    const float gq0 = qn[l16], gq1 = qn[16 + l16], gq2 = qn[32 + l16], gq3 = qn[48 + l16], gk0 = kn[l16], gk1 = kn[16 + l16], gk2 = kn[32 + l16], gk3 = kn[48 + l16];
    for (int row = gw; row < MR + NMROWS; row += NGW) {
        int pr = 0, pc = 0; if (row < MR) { const int t = row & (SEQL - 1); pr = t >> 6; pc = t & 63; }
        const f32x2 cr = tab[pr * 16 + l16], cc = tab[pc * 16 + l16];
        const bf16_t* src = QKV + (size_t)row * 1536 + hq * 64 + l16;
        unsigned short xin[5][4];
#pragma unroll
        for (int pass = 0; pass < 5; ++pass)
#pragma unroll
            for (int q = 0; q < 4; ++q) xin[pass][q] = src[pass * 256 + 16 * q];
#pragma unroll
        for (int pass = 0; pass < 5; ++pass) {
            const bool isq = pass < 4;
            float x0 = bf2f(xin[pass][0]), x1 = bf2f(xin[pass][1]), x2 = bf2f(xin[pass][2]), x3 = bf2f(xin[pass][3]);
            float ssq = (x0 * x0 + x1 * x1) + (x2 * x2 + x3 * x3);
            ssq += __shfl_xor(ssq, 1); ssq += __shfl_xor(ssq, 2); ssq += __shfl_xor(ssq, 4); ssq += __shfl_xor(ssq, 8);
            const float rs = rsqrtf(ssq * (1.0f / 64.0f) + RMS_EPS);
            x0 *= rs * (isq ? gq0 : gk0); x1 *= rs * (isq ? gq1 : gk1); x2 *= rs * (isq ? gq2 : gk2); x3 *= rs * (isq ? gq3 : gk3);
            float o0 = x0 * cr.x - x1 * cr.y, o1 = x1 * cr.x + x0 * cr.y, o2 = x2 * cc.x - x3 * cc.y, o3 = x3 * cc.x + x2 * cc.y;
            if (isq) { o0 *= C2; o1 *= C2; o2 *= C2; o3 *= C2; }
            bf16_t* q = DST + (size_t)row * 1536 + (pass * 4 + hq) * 64 + l16;
            q[0] = (bf16_t)(pk2(o0, 0.f) & 0xffffu); q[16] = (bf16_t)(pk2(o1, 0.f) & 0xffffu); q[32] = (bf16_t)(pk2(o2, 0.f) & 0xffffu); q[48] = (bf16_t)(pk2(o3, 0.f) & 0xffffu);
        }
    }
}
constexpr int QP = 136, TP = 72;
constexpr int ML_BUF = 60160, ML_OK = 17408, ML_OKT = 34816, ML_OVT = 53248;
constexpr int ML_SS = 2 * ML_BUF, ML_SC = ML_SS + 18432  , ML_SCB = 34 * 272  , ML_SZ = ML_SC + 2 * ML_SCB  , ML_G = ML_SZ + 272, ML_GB = 1552, ML_CH = ML_G + 2 * ML_GB;
__device__ __forceinline__ long ml_row(int b, int dir, int ci, int s) {
    if (dir == 0) { if (ci == 0) return (s < 16) ? (long)MR + b * 16 + s : -1; return (long)b * SEQL + (ci - 1) * 64 + s; }
    if (ci < 128) return (long)b * SEQL + (127 - ci) * 64 + (63 - s);
    return (s < 16) ? (long)MR + b * 16 + 15 - s : -1;
}
__device__ __forceinline__ void mlstm_item(LAS unsigned char* lds, const bf16_t* __restrict__ P, const float* __restrict__ gates, const float* __restrict__ gbias, bf16_t* __restrict__ Hout, float* __restrict__ gsc, int b, int head, int dir, int sl) {
    const int tid = opaque_tid(), lane = tid & 63, wave = tid >> 6, l16 = lane & 15, g = lane >> 4;
    LAS bf16_t* sS = (LAS bf16_t*)(lds + ML_SS) + wave * 16 * TP;
    LAS bf16_t* sC0 = (LAS bf16_t*)(lds + ML_SC); const LAS bf16_t* sZ = (const LAS bf16_t*)(lds + ML_SZ);
    LAS float* sBlast = (LAS float*)(lds + ML_CH); LAS float* sPml = sBlast + 132; LAS float* sMprev = sPml + 132;
    const float kscale = 0.08838834764831845f;
    const float bias_i = gbias[(2 * dir) * 4 + head], bias_f = gbias[(2 * dir + 1) * 4 + head];
    float pgi[17], pgf[17];
#pragma unroll
    for (int k = 0; k < 17; ++k) { const int ci = wave + NWAVES * k; pgi[k] = 0.f; pgf[k] = 0.f;
        if (ci < 129) { const long row = ml_row(b, dir, ci, lane); if (row >= 0) { pgi[k] = gates[row * 16 + (2 * dir) * 4 + head]; pgf[k] = gates[row * 16 + (2 * dir + 1) * 4 + head]; } } }
#pragma unroll
    for (int k = 0; k < 17; ++k) { const int ci = wave + NWAVES * k; if (ci >= 129) break;
        const long row = ml_row(b, dir, ci, lane); const bool valid = row >= 0;
        const float gi = pgi[k], gf = pgf[k];
        const float xf = gf + bias_f;
        const float li = valid ? gi + bias_i : -INFINITY;
        const float lf = valid ? (fminf(xf, 0.f) - __logf(1.f + __expf(-fabsf(xf)))) : 0.f;
        float bc = lf;
#pragma unroll
        for (int o = 1; o < 64; o <<= 1) { const float t = __shfl_up(bc, o); if (lane >= o) bc += t; }
        const float av = li - bc;
        float pm = av;
#pragma unroll
        for (int o = 1; o < 64; o <<= 1) { const float t = __shfl_up(pm, o); if (lane >= o) pm = fmaxf(pm, t); }
        *(f32x4*)(gsc + ((size_t)ci * 64 + lane) * 4) = (f32x4){bc, av, pm, 0.f};
        if (lane == 63) { sBlast[ci] = bc; sPml[ci] = pm; }
    }
    for (int i = tid; i < (2 * ML_SCB + 272) / 2; i += NTHR) sC0[i] = 0;
    for (int i = tid; i < 2 * 16 * TP; i += NTHR) { const int bsel = i / (16 * TP), rem = i - bsel * (16 * TP); const int rw = rem / TP;
        ((LAS bf16_t*)(lds + bsel * ML_BUF + ML_OVT))[(32 + rw) * TP + (rem - rw * TP)] = (rw == 0) ? (bf16_t)0x3F80 : (bf16_t)0; }
    __syncthreads();
    if (tid == 0) { float m = 0.f; for (int ci = 0; ci < 129; ++ci) { sMprev[ci] = m; const float bl = sBlast[ci]; m = fmaxf(bl + m, bl + sPml[ci]); } }
    __syncthreads();
    f32x4 accC[3]; accC[0] = (f32x4){0.f, 0.f, 0.f, 0.f}; accC[1] = accC[0]; accC[2] = accC[0];
    const int ss_ = tid >> 3, d0 = (tid & 7) * 16;
    const int vs_ = tid >> 2, v0 = (tid & 3) * 8;
    u32x4 rq0, rq1, rk0, rk1, rv; f32x4 rgs = (f32x4){0.f, 0.f, 0.f, 0.f}; long rrow = -1;
    const int meta_ci = dir ? 128 : 0, rstride = dir ? -64 : 64;
    const int linQ = dir ? b * SEQL + 127 * 64 + 63 - ss_ : b * SEQL - 64 + ss_, metaQ = (ss_ < 16) ? MR + b * 16 + (dir ? 15 - ss_ : ss_) : -1;
    const int linV = dir ? b * SEQL + 127 * 64 + 63 - vs_ : b * SEQL - 64 + vs_, metaV = (vs_ < 16) ? MR + b * 16 + (dir ? 15 - vs_ : vs_) : -1;
    const int linG = dir ? b * SEQL + 127 * 64 + 63 - tid : b * SEQL - 64 + tid, metaG = (tid < 16) ? MR + b * 16 + (dir ? 15 - tid : tid) : -1;
#define ML_LOAD(ci) do { \
        long row_ = ((ci) == meta_ci) ? metaQ : linQ + rstride * (ci); row_ = (row_ >= 0) ? row_ : (long)b * SEQL;     \
        { const bf16_t* pr_ = P + row_ * 3072 + head * 128 + d0; rq0 = *(const u32x4*)pr_; rq1 = *(const u32x4*)(pr_ + 8); rk0 = *(const u32x4*)(pr_ + 512); rk1 = *(const u32x4*)(pr_ + 520); } \
        if (tid < 256) { long rowv_ = ((ci) == meta_ci) ? metaV : linV + rstride * (ci); rowv_ = (rowv_ >= 0) ? rowv_ : (long)b * SEQL; rv = *(const u32x4*)(P + rowv_ * 3072 + 1024 + head * 256 + sl * 32 + v0); } \
        if (tid < 64) { rrow = ((ci) == meta_ci) ? metaG : linG + rstride * (ci); rrow = (rrow >= 0) ? rrow : (long)(MP - 1);     rgs = *(const f32x4*)(gsc + ((size_t)(ci) * 64 + tid) * 4); } \
    } while (0)
#define ML_STAGE(cs, nb) do { \
        LAS bf16_t* sQ_ = (LAS bf16_t*)(lds + (nb) * ML_BUF); LAS bf16_t* sK_ = (LAS bf16_t*)(lds + (nb) * ML_BUF + ML_OK); LAS bf16_t* sKt_ = (LAS bf16_t*)(lds + (nb) * ML_BUF + ML_OKT); LAS bf16_t* sVt_ = (LAS bf16_t*)(lds + (nb) * ML_BUF + ML_OVT); \
        *(LAS u32x4*)(sQ_ + ss_ * QP + d0) = rq0; *(LAS u32x4*)(sQ_ + ss_ * QP + d0 + 8) = rq1; \
        *(LAS u32x4*)(sK_ + ss_ * QP + d0) = rk0; *(LAS u32x4*)(sK_ + ss_ * QP + d0 + 8) = rk1; \
        { const unsigned kw_[8] = {rk0.x, rk0.y, rk0.z, rk0.w, rk1.x, rk1.y, rk1.z, rk1.w}; \
          const int sc_ = ((((ss_ >> 3) ^ (d0 >> 4)) << 3) | (ss_ & 7)); \
          _Pragma("unroll") for (int e = 0; e < 8; ++e) { sKt_[(d0 + 2 * e) * TP + sc_] = (bf16_t)(kw_[e] & 0xffffu); sKt_[(d0 + 2 * e + 1) * TP + sc_] = (bf16_t)(kw_[e] >> 16); } } \
        if (tid < 256) { const unsigned vw_[4] = {rv.x, rv.y, rv.z, rv.w}; \
          const int vc_ = ((((vs_ >> 3) ^ (v0 >> 3)) << 3) | (vs_ & 7)); \
          _Pragma("unroll") for (int e = 0; e < 4; ++e) { sVt_[(v0 + 2 * e) * TP + vc_] = (bf16_t)(vw_[e] & 0xffffu); sVt_[(v0 + 2 * e + 1) * TP + vc_] = (bf16_t)(vw_[e] >> 16); } } \
        if (tid < 64) { LAS float* G_ = (LAS float*)(lds + ML_G + (nb) * ML_GB); \
            const float bc_ = rgs[0], av_ = rgs[1], pm_ = rgs[2], mp_ = sMprev[(cs)], bl_ = sBlast[(cs)]; \
            const float mn_ = fmaxf(bl_ + mp_, bl_ + sPml[(cs)]), in_ = bc_ + mp_, mt_ = fmaxf(in_, bc_ + pm_); \
            const float pl_ = sPml[(cs)]; G_[tid] = __expf(bc_ - mt_ + pl_); G_[64 + tid] = __expf(av_ - 2.4260151319598084f   - pl_);     G_[128 + tid] = __expf(in_ - mt_); G_[192 + tid] = __expf(-mt_); G_[256 + tid] = __expf(bl_ + av_ - mn_) * kscale; \
            ((LAS int*)G_)[320 + tid] = (int)rrow; if (tid == 0) G_[384] = __expf(bl_ + mp_ - mn_); } \
    } while (0)
    ML_LOAD(0);
    ML_STAGE(0, 0);
    __syncthreads();
    const int tt = wave >> 1, vt = wave & 1; const int ttu = __builtin_amdgcn_readfirstlane(tt);
    for (int ci = 0; ci < 129; ++ci) {
        const int cur = ci & 1;
        const LAS bf16_t* sQ = (const LAS bf16_t*)(lds + cur * ML_BUF); const LAS bf16_t* sK = (const LAS bf16_t*)(lds + cur * ML_BUF + ML_OK);
        const LAS bf16_t* sKt = (const LAS bf16_t*)(lds + cur * ML_BUF + ML_OKT); const LAS bf16_t* sVt = (const LAS bf16_t*)(lds + cur * ML_BUF + ML_OVT);
        const LAS float* G = (const LAS float*)(lds + ML_G + cur * ML_GB);
        const LAS bf16_t* sC = sC0 + cur * (ML_SCB / 2); LAS bf16_t* sCn = sC0 + (cur ^ 1) * (ML_SCB / 2);
        if (ci + 1 < 129) ML_LOAD(ci + 1);
        bf16x8 qf[4];
#pragma unroll
        for (int ks = 0; ks < 4; ++ks) qf[ks] = *(const LAS bf16x8*)(sQ + (tt * 16 + l16) * QP + 32 * ks + 8 * g);
        const float ebt = G[tt * 16 + l16];
#pragma unroll
        for (int st = 0; st < 4; ++st) {
            if (st <= ttu) {
                f32x4 acc = (f32x4){0.f, 0.f, 0.f, 0.f};
#pragma unroll
                for (int ks = 0; ks < 4; ++ks) acc = mfma16(*(const LAS bf16x8*)(sK + (st * 16 + l16) * QP + 32 * ks + 8 * g), qf[ks], acc);
                const f32x4 ea = *(const LAS f32x4*)(G + 64 + st * 16 + 4 * g); const int s0_ = st * 16 + 4 * g, tl = tt * 16 + l16;
                float v[4];
#pragma unroll
                for (int e = 0; e < 4; ++e) v[e] = (s0_ + e <= tl) ? acc[e] * (ebt * ea[e]) : 0.f;
                u32x2 w2; w2.x = pk2(v[0], v[1]); w2.y = pk2(v[2], v[3]);
                *(LAS u32x2*)(sS + l16 * TP + st * 16 + 4 * g) = w2;
            } else {
                *(LAS u32x2*)(sS + l16 * TP + st * 16 + 4 * g) = (u32x2){0u, 0u};
            }
        }
        const int tl_ = tt * 16 + l16;
        const float wi = G[128 + tl_], ei = G[192 + tl_]; const int orow = ((const LAS int*)G)[320 + tl_];
        f32x4 acch = (f32x4){0.f, 0.f, 0.f, 0.f}, accd = acch;
#pragma unroll
        for (int ks = 0; ks < 4; ++ks) { acch = mfma16(*(const LAS bf16x8*)(sC + (vt * 16 + l16) * QP + 32 * ks + 8 * g), qf[ks], acch);
                                          accd = mfma16(*(const LAS bf16x8*)(((l16 == 0) ? sC + 32 * QP : sZ) + 32 * ks + 8 * g), qf[ks], accd); }
#pragma unroll
        for (int e = 0; e < 4; ++e) { acch[e] *= wi; accd[e] *= wi; }
#pragma unroll
        for (int ks = 0; ks < 2; ++ks) { const bf16x8 sf = *(const LAS bf16x8*)(sS + l16 * TP + 32 * ks + 8 * g);
            acch = mfma16(*(const LAS bf16x8*)(sVt + (vt * 16 + l16) * TP + (((4 * ks + g) ^ ((2 * vt + (l16 >> 3)) & 3)) << 3)), sf, acch);
            accd = mfma16(*(const LAS bf16x8*)(sVt + (32 + l16) * TP + 32 * ks + 8 * g), sf, accd); }
        { const float den = __shfl(accd[0], l16);
          const float rd = frcp(fmaxf(fabsf(den), ei));
          u32x2 w2; w2.x = pk2(acch[0] * rd, acch[1] * rd); w2.y = pk2(acch[2] * rd, acch[3] * rd);
          *(u32x2*)(Hout + (size_t)orow * 1024 + head * 256 + sl * 32 + vt * 16 + 4 * g) = w2; }
        {
            const float decay = G[384]; const int dt = wave;
            bf16x8 bfr[2];
#pragma unroll
            for (int ks = 0; ks < 2; ++ks) { const u32x4 kw = *(const LAS u32x4*)(sKt + (dt * 16 + l16) * TP + (((4 * ks + g) ^ dt) << 3));
                const f32x4 w0 = *(const LAS f32x4*)(G + 256 + 32 * ks + 8 * g), w1 = *(const LAS f32x4*)(G + 256 + 32 * ks + 8 * g + 4);
                u32x4 o; o.x = pk2(bflo(kw.x) * w0[0], bfhi(kw.x) * w0[1]); o.y = pk2(bflo(kw.y) * w0[2], bfhi(kw.y) * w0[3]); o.z = pk2(bflo(kw.z) * w1[0], bfhi(kw.z) * w1[1]); o.w = pk2(bflo(kw.w) * w1[2], bfhi(kw.w) * w1[3]);
                bfr[ks] = __builtin_bit_cast(bf16x8, o); }
#pragma unroll
            for (int v2 = 0; v2 < 3; ++v2) {
                accC[v2] = accC[v2] * decay;
#pragma unroll
                for (int ks = 0; ks < 2; ++ks) accC[v2] = mfma16(bfr[ks], *(const LAS bf16x8*)(sVt + (v2 * 16 + l16) * TP + (((4 * ks + g) ^ ((2 * v2 + (l16 >> 3)) & 3)) << 3)), accC[v2]);
                u32x2 w2; w2.x = pk2(accC[v2][0], accC[v2][1]); w2.y = pk2(accC[v2][2], accC[v2][3]);
                if (v2 < 2) *(LAS u32x2*)(sCn + (v2 * 16 + l16) * QP + dt * 16 + 4 * g) = w2;
                else if (l16 == 0) *(LAS u32x2*)(sCn + 32 * QP + dt * 16 + 4 * g) = w2;
            }
        }
        if (ci + 1 < 129) ML_STAGE(ci + 1, cur ^ 1);
        __syncthreads();
    }
#undef ML_LOAD
#undef ML_STAGE
}
__device__ __forceinline__ void mlstm_phase(LAS unsigned char* lds, const bf16_t* P, const float* gates, const float* gbias, bf16_t* HF, bf16_t* HBW, float* gsc_all) {
    for (int it = blockIdx.x; it < 256; it += gridDim.x) {
        const int xq = it & 7, lq = it >> 3; const int sl = lq & 7, ch = xq * 4 + (lq >> 3); const int dir = ch & 1, head = (ch >> 1) & 3, b = ch >> 3;
        mlstm_item(lds, P, gates, gbias, dir ? HBW : HF, gsc_all + (size_t)it * 129 * 64 * 4, b, head, dir, sl);
        __syncthreads();
    }
}
__device__ __forceinline__ void mlstm_combine_phase(const bf16_t* P, const bf16_t* HF, bf16_t* AO, const float* onorm) {
    const int tid = opaque_tid(), lane = tid & 63, wave = tid >> 6;
    const int gw = blockIdx.x * NWAVES + wave, NGW = gridDim.x * NWAVES;
    for (int row = gw; row < MR + NMROWS; row += NGW) {
        u32x2 a[4], c[4], op[4];
#pragma unroll
        for (int hd = 0; hd < 4; ++hd) { const int col = hd * 256 + 4 * lane;
            a[hd] = *(const u32x2*)(HF + (size_t)row * 1024 + col); c[hd] = *(const u32x2*)(AO + (size_t)row * 1024 + col); op[hd] = *(const u32x2*)(P + (size_t)row * 3072 + 2048 + col); }
#pragma unroll
        for (int hd = 0; hd < 4; ++hd) {
            const int col = hd * 256 + 4 * lane;
            float h0 = bflo(a[hd].x) + bflo(c[hd].x), h1 = bfhi(a[hd].x) + bfhi(c[hd].x), h2 = bflo(a[hd].y) + bflo(c[hd].y), h3 = bfhi(a[hd].y) + bfhi(c[hd].y);
            const float ssq = wave_sum((h0 * h0 + h1 * h1) + (h2 * h2 + h3 * h3));
            const float rs = rsqrtf(ssq * (1.0f / 256.0f) + RMS_EPS);
            const f32x4 gn = *(const f32x4*)(onorm + col);
            const float o0 = bflo(op[hd].x), o1 = bfhi(op[hd].x), o2 = bflo(op[hd].y), o3 = bfhi(op[hd].y);
            h0 = h0 * rs * gn[0] * frcp(1.f + __expf(-o0)); h1 = h1 * rs * gn[1] * frcp(1.f + __expf(-o1)); h2 = h2 * rs * gn[2] * frcp(1.f + __expf(-o2)); h3 = h3 * rs * gn[3] * frcp(1.f + __expf(-o3));
            u32x2 w; w.x = pk2(h0, h1); w.y = pk2(h2, h3); *(u32x2*)(AO + (size_t)row * 1024 + col) = w;
        }
    }
}
__device__ __forceinline__ void final_phase(const bf16_t* hin, float* out, const float* ss, const float* gfin, long nperturb) {
    const int tid = opaque_tid(), lane = tid & 63, wave = tid >> 6;
    const int gw = blockIdx.x * NWAVES + wave, NGW = gridDim.x * NWAVES;
    for (int row0 = gw; row0 < MR; row0 += 4 * NGW) {
        u32x2 hw[4][4]; float rs[4];
#pragma unroll
        for (int q = 0; q < 4; ++q) { const int row = min(row0 + q * NGW, MR - 1); rs[q] = rstd_of(ss + (size_t)row * 16);
#pragma unroll
            for (int j = 0; j < 4; ++j) hw[q][j] = *(const u32x2*)(hin + (size_t)row * 1024 + 256 * j + 4 * lane); }
#pragma unroll
        for (int q = 0; q < 4; ++q) { const int row = row0 + q * NGW; if (row < MR) {
#pragma unroll
            for (int j = 0; j < 4; ++j) { const f32x4 gn = *(const f32x4*)(gfin + 256 * j + 4 * lane); f32x4 v;
                v[0] = bflo(hw[q][j].x) * rs[q] * gn[0]; v[1] = bfhi(hw[q][j].x) * rs[q] * gn[1]; v[2] = bflo(hw[q][j].y) * rs[q] * gn[2]; v[3] = bfhi(hw[q][j].y) * rs[q] * gn[3];
                *(f32x4*)(out + (size_t)row * 1024 + 256 * j + 4 * lane) = v; } } }
    }
}

__device__ __forceinline__ void attn_meta_combine_phase(const bf16_t* po, const float* pml, bf16_t* AO) {
    const int gt = blockIdx.x * NTHR + opaque_tid();
    if (gt < 4 * 16 * 16 * 8) {
        const int c8 = gt & 7, r = (gt >> 3) & 15, hd = (gt >> 7) & 15, b = gt >> 11;
        float m[4], l[4], M = -INFINITY;
#pragma unroll
        for (int s = 0; s < 4; ++s) { const size_t pi = (size_t)(((b * 4 + s) * 16 + hd) * 16 + r); m[s] = pml[pi * 2]; l[s] = pml[pi * 2 + 1]; M = fmaxf(M, m[s]); }
        float acc[8] = {0.f, 0.f, 0.f, 0.f, 0.f, 0.f, 0.f, 0.f}, wsum = 0.f;
#pragma unroll
        for (int s = 0; s < 4; ++s) { const size_t pi = (size_t)(((b * 4 + s) * 16 + hd) * 16 + r); const float w = l[s] * exp2f(m[s] - M); wsum += w;
            const u32x4 v = *(const u32x4*)(po + pi * 64 + c8 * 8);
            acc[0] += w * bflo(v.x); acc[1] += w * bfhi(v.x); acc[2] += w * bflo(v.y); acc[3] += w * bfhi(v.y); acc[4] += w * bflo(v.z); acc[5] += w * bfhi(v.z); acc[6] += w * bflo(v.w); acc[7] += w * bfhi(v.w); }
        const float inv = 1.0f / wsum;
        u32x4 o; o.x = pk2(acc[0] * inv, acc[1] * inv); o.y = pk2(acc[2] * inv, acc[3] * inv); o.z = pk2(acc[4] * inv, acc[5] * inv); o.w = pk2(acc[6] * inv, acc[7] * inv);
        *(u32x4*)(AO + (size_t)(MR + b * 16 + r) * 1024 + hd * 64 + c8 * 8) = o;
    }
}

constexpr int N_PHASES = 30;
#ifndef REP_NA
#define REP_NA 1
#endif
#ifndef REP_ATTN
#define REP_ATTN 1
#endif
#ifndef REP_ML
#define REP_ML 1
#endif
#ifndef REP_G0
#define REP_G0 1
#endif
#ifndef REP_G2
#define REP_G2 1
#endif
#ifndef REP_PRO
#define REP_PRO 1
#endif
#ifndef REP_SYNC
#define REP_SYNC 1
#endif
#ifndef REP_DRY
#define REP_DRY 1
#endif
#ifndef EN_PRO
#define EN_PRO 1
#endif
#ifndef EN_GEMM0
#define EN_GEMM0 1
#endif
#ifndef EN_GEMM1
#define EN_GEMM1 1
#endif
#ifndef EN_GEMM2
#define EN_GEMM2 1
#endif
#ifndef EN_NA
#define EN_NA 1
#endif
#ifndef EN_ATTN
#define EN_ATTN 1
#endif
#ifndef EN_ML
#define EN_ML 1
#endif
__device__ __forceinline__ bool phase_active(int ph) {
    if (ph == 0 || ph == 29) return true;
    const int layer = (ph - 1) / 7, s = (ph - 1) % 7;
    if (s == 1) return layer == 1;
    if (s == 3) return layer == 2 || layer == 1;
    return true;
}
__global__ void __launch_bounds__(NTHR, 2) fwd_kernel(Args args) {
    extern __shared__ __attribute__((aligned(16))) unsigned char lds_raw[];
    LAS unsigned char* lds = (LAS unsigned char*)lds_raw;
    cg::grid_group grid = cg::this_grid();
    unsigned char* ws = args.ws;
    bf16_t* HB = (bf16_t*)(ws + OFF_HB); bf16_t* AO = (bf16_t*)(ws + OFF_AO); bf16_t* QKV = (bf16_t*)(ws + OFF_QKV); bf16_t* VT = (bf16_t*)(ws + OFF_VT);
    float* SS = (float*)(ws + OFF_SS); float* GATES = (float*)(ws + OFF_GATES);
    if (threadIdx.x < 32) ((LAS unsigned*)(lds + MISC_OFF))[threadIdx.x] = 0u;
    __syncthreads();
    XcdBarrier bar = xcd_barrier_post((unsigned*)(ws + OFF_BAR), (volatile LAS unsigned*)(lds + MISC_OFF) + 8);
    bool did = false; int nsync = 0;
    for (int ph = args.ph_lo; ph < args.ph_hi; ++ph) {
        if (!phase_active(ph)) continue;
        if (did) for (int rep_ = 0; rep_ < REP_SYNC; ++rep_) { if (args.ph_lo < 0) grid.sync();
            xcd_barrier(bar); ++nsync; }
        did = true;
        if (ph == 0) { if (EN_PRO) for (int rep_ = 0; rep_ < REP_PRO; ++rep_) { prologue_phase(args, lds); __syncthreads(); } continue; }
        if (PROBE_ON && blockIdx.x == 0 && threadIdx.x == 0) ((unsigned long long*)(ws + OFF_TS))[ph] = __builtin_amdgcn_s_memrealtime();
        if (ph == 29) { long np = 0;
            if (PROBE_ON) { const unsigned long long* ts = (const unsigned long long*)(ws + OFF_TS); long ta = 0, tb = 0;
                for (int p = 0; p < 29; ++p) { if (!phase_active(p)) continue; int q = p + 1; while (!phase_active(q)) ++q; const long d = (long)(ts[q] - ts[p]);
                    const int sp = (p == 0) ? 7 : (p - 1) % 7; if ((PROBE_A >> sp) & 1) ta += d; if ((PROBE_B >> sp) & 1) tb += d; }
                long a = ta / 2000, b = tb / 2000; if (a > 99) a = 99; if (b > 99) b = 99; np = (a * 20000 + b * 200) & ~3L; }
            final_phase(HB, args.out, SS + (size_t)8 * MP * 16, args.in[4], np); continue; }
        const int layer = (ph - 1) / 7, s = (ph - 1) % 7;
        const int kind = (layer == 1) ? 1 : (layer == 2) ? 2 : 0, ja = (layer == 3) ? 1 : 0;
        const float* ss_mix = SS + (size_t)(2 * layer) * MP * 16; float* ss_ffn = SS + (size_t)(2 * layer + 1) * MP * 16; float* ss_next = SS + (size_t)(2 * layer + 2) * MP * 16;
        if (s == 0) { if (EN_GEMM0) for (int rep_ = 0; rep_ < REP_G0; ++rep_) {
            const bf16_t* W = (kind == 0) ? (const bf16_t*)(ws + OFF_W_AQKV + (size_t)ja * 6 * MiB) : (kind == 1) ? (const bf16_t*)(ws + OFF_W_BQKV) : (const bf16_t*)(ws + OFF_W_CIN);
            const int N = (kind == 0) ? 2048 : (kind == 1) ? 1536 : 3072;
            const int ldc = (kind == 0) ? 2048 : (kind == 1) ? 1536 : 3072;
            { const StripEpi SE{SE_SCALE, QKV, ldc, ss_mix, nullptr, nullptr, nullptr}; strip_phase(lds, HB + (size_t)MR * 1024, W, 1024, N / 64, false, SE); }
            if (kind == 2) gates_phase(HB, W + (size_t)3072 * 1024, ss_mix, GATES);
            pg8::Gemm gm{HB, W, MR, N, 1024}; pg8::StaticOrder S; S.init(MR, N, gridDim.x, blockIdx.x);
            EpiScaleBf16 E{QKV, ldc, ss_mix};
            pg8::gemm_phase<EpiScaleBf16, pg8::StaticOrder, PG_ALIGN, PG_SP2>(lds, gm, S, E);
            if (kind == 0) {
                { const StripEpi SE{SE_SCALECOL, VT, MP, ss_mix, nullptr, nullptr, nullptr}; strip_phase(lds, W + (size_t)2048 * 1024, HB + (size_t)MR * 1024, 1024, 16, true, SE, 64); }
                pg8::Gemm g2{W + (size_t)2048 * 1024, HB, 1024, MR, 1024}; pg8::StaticOrder S2; S2.init(1024, MR, gridDim.x, blockIdx.x);
                EpiScaleColBf16 E2{VT, MP, ss_mix};
                pg8::gemm_phase<EpiScaleColBf16, pg8::StaticOrder, PG_ALIGN, PG_SP2>(lds, g2, S2, E2);
            } }
        } else if (s == 1) {
            rope_phase(QKV, QKV, args.in[10], args.in[11], (const f32x2*)(ws + OFF_ROPE));
        } else if (s == 2) {
            if (kind == 0) { if (EN_NA) for (int rep_ = 0; rep_ < REP_NA; ++rep_) na_phase(lds, QKV, VT, args.in[6] + (size_t)ja * 16 * 465, args.in[7] + (size_t)ja * 256, AO); }
            else if (kind == 1) { if (EN_ATTN) for (int rep_ = 0; rep_ < REP_ATTN; ++rep_) {
                const int xcd = blockIdx.x & 7, l = blockIdx.x >> 3; const bool g256 = (gridDim.x == 256);
                const int nun = g256 ? 8 : (2048 - (int)blockIdx.x + (int)gridDim.x - 1) / (int)gridDim.x;
                for (int i = 0; i < nun; ++i) {
                    int b_, h_, qb_;
                    if (g256) { const int pair = 2 * xcd + (i >> 2); b_ = pair >> 2; h_ = (pair & 3) * 4 + (i & 3); qb_ = l; }
                    else { const int u = blockIdx.x + i * gridDim.x; b_ = u >> 9; h_ = (u >> 5) & 15; qb_ = u & 31; }
                    attn_body::attn_unit<8, false>(b_, h_, qb_, 0, 130, (const attn_body::bf16*)QKV, (attn_body::bf16*)AO, nullptr, nullptr, (char*)lds_raw);
                }
                for (int mu = blockIdx.x; mu < 64; mu += gridDim.x)
                    attn_body::attn_unit<8, true>(mu >> 4, ((mu >> 2) & 3) * 4, 32, 32 * (mu & 3), ((mu & 3) == 3) ? 34 : 32, (const attn_body::bf16*)QKV, (attn_body::bf16*)AO, (attn_body::bf16*)(ws + OFF_HX), (float*)(ws + OFF_HX + 524288), (char*)lds_raw);
                if (g256) { if (blockIdx.x >= 64) { __syncthreads(); weight_items<1>(args, lds, (int)blockIdx.x - 64, 192); } }
                else { __syncthreads(); weight_items<1>(args, lds, (int)blockIdx.x, (int)gridDim.x); }
                }
            } else { if (EN_ML) for (int rep_ = 0; rep_ < REP_ML; ++rep_) mlstm_phase(lds, QKV, GATES, args.in[14], (bf16_t*)args.out  , AO, (float*)(ws + OFF_GSC)); }
        } else if (s == 3) {
            if (layer == 1) attn_meta_combine_phase((const bf16_t*)(ws + OFF_HX), (const float*)(ws + OFF_HX + 524288), AO);
            else mlstm_combine_phase(QKV, (const bf16_t*)args.out, AO, args.in[15]);
        } else if (s == 4 || s == 6) { if (EN_GEMM1) {
            const bf16_t* W = (s == 6) ? (const bf16_t*)(ws + OFF_W2 + (size_t)layer * 11 * MiB / 2)
                            : (kind == 0) ? (const bf16_t*)(ws + OFF_W_AO + (size_t)ja * 2 * MiB) : (kind == 1) ? (const bf16_t*)(ws + OFF_W_BO) : (const bf16_t*)(ws + OFF_W_CO);
            const int Kd = (s == 6) ? FFH : 1024; const bf16_t* Ain = (s == 6) ? QKV : AO; float* ssw = (s == 6) ? ss_next : ss_ffn;
            { const StripEpi SE{SE_RESID, nullptr, 0, nullptr, nullptr, HB, ssw}; strip_phase(lds, Ain + (size_t)MR * Kd, W, Kd, 16, false, SE); }
            pg8::Gemm gm{Ain, W, MR, 1024, Kd}; pg8::StaticOrder S; S.init(MR, 1024, gridDim.x, blockIdx.x);
            EpiResid E{HB, ssw};
            pg8::gemm_phase<EpiResid, pg8::StaticOrder, PG_ALIGN, PG_SP2>(lds, gm, S, E); }
        } else if (EN_GEMM2) for (int rep_ = 0; rep_ < REP_G2; ++rep_) {
            const bf16_t* W13 = (const bf16_t*)(ws + OFF_W13 + (size_t)layer * 11 * MiB);
            { const StripEpi SE{SE_SWIGLU, QKV, 0, ss_ffn, nullptr, nullptr, nullptr}; strip_phase(lds, HB + (size_t)MR * 1024, W13, 1024, 88, false, SE); }
            pg8::Gemm gm{HB, W13, MR, 2 * FFH, 1024}; pg8::StaticOrder S; S.init(MR, 2 * FFH, gridDim.x, blockIdx.x);
            EpiSwiglu E{QKV, ss_ffn};
            pg8::gemm_phase<EpiSwiglu, pg8::StaticOrder, PG_ALIGN, PG_SP2>(lds, gm, S, E);
        }
    }
}

#ifndef ONE_LAUNCH
#define ONE_LAUNCH 1
#endif
extern "C" void kernel_launch(void* const* d_in, const int* in_sizes, int n_in, void* d_out, int out_size, void* d_ws, size_t ws_size, hipStream_t stream) {
    static int grid = 0;
    if (grid == 0) {
        if (n_in != 20 || out_size != MR * 1024 || ws_size < WS_END) { fprintf(stderr, "kernel_launch: unexpected shapes (n_in %d out %d ws %zu)\n", n_in, out_size, ws_size); grid = -1; return; }
        int dev = 0, cus = 0, per_cu = 0;
        hipGetDevice(&dev); hipDeviceGetAttribute(&cus, hipDeviceAttributeMultiprocessorCount, dev);
        if (hipFuncSetAttribute((const void*)fwd_kernel, hipFuncAttributeMaxDynamicSharedMemorySize, LDS_BYTES) != hipSuccess) { fprintf(stderr, "kernel_launch: hipFuncSetAttribute failed\n"); grid = -1; return; }
        if (hipOccupancyMaxActiveBlocksPerMultiprocessor(&per_cu, (const void*)fwd_kernel, NTHR, LDS_BYTES) != hipSuccess || per_cu < 1) { fprintf(stderr, "kernel_launch: occupancy query says %d\n", per_cu); per_cu = 1; }
        (void)hipGetLastError();
        grid = cus;
    }
    if (grid < 0) return;
    if (hipMemsetAsync((char*)d_ws + OFF_BAR, 0, BAR_BYTES, stream) != hipSuccess) { fprintf(stderr, "kernel_launch: memset of the barrier words failed\n"); return; }
    Args a{};
    for (int i = 0; i < 20; ++i) a.in[i] = (const float*)d_in[i];
    a.out = (float*)d_out; a.ws = (unsigned char*)d_ws;
#if ONE_LAUNCH
    a.ph_lo = 0; a.ph_hi = N_PHASES;
    void* kargs[] = {&a};
    hipError_t e = hipLaunchCooperativeKernel((const void*)fwd_kernel, dim3(grid), dim3(NTHR), kargs, LDS_BYTES, stream);
    if (e != hipSuccess) fprintf(stderr, "kernel_launch: cooperative launch failed: %s (grid %d)\n", hipGetErrorString(e), grid);
#else
    for (int ph = 0; ph < N_PHASES; ++ph) {
        a.ph_lo = ph; a.ph_hi = ph + 1;
        hipLaunchKernelGGL(fwd_kernel, dim3(grid), dim3(NTHR), LDS_BYTES, stream, a);
    }
#endif
}
```
